# Optimizing an MI355X kernel written in HIP

```python
import jax, jax.numpy as jnp
from jax import lax
import numpy as np

D_MODEL = 1024
BATCH = 8
SEQ = 4096
DEPTH = 2

CHUNK = 64
Q_BLOCK = 128
D_FF = 2816
EPS = 1e-6
ROPE_BASE = 10000.0
ROPE_DIM = 32

MLA_HEADS = 8
MLA_Q_RANK = 256
MLA_KV_RANK = 128
MLA_NOPE = 64
MLA_ROPE = ROPE_DIM
MLA_V = 64
GLA_HEADS = 4
GLA_DK = 32
GLA_DV = 64
GLA_GATE_RANK = 16
GLA_TAU = 16.0
RET_HEADS = 4
RET_DK = ROPE_DIM
RET_DV = 64

MLA_WIDTH = MLA_HEADS * MLA_V
GLA_WIDTH = GLA_HEADS * GLA_DV
RET_WIDTH = RET_HEADS * RET_DV
MIX_WIDTH = MLA_WIDTH + GLA_WIDTH + RET_WIDTH

IN_SPLITS = (
    MLA_Q_RANK, MLA_KV_RANK, MLA_ROPE,
    GLA_HEADS * GLA_DK, GLA_HEADS * GLA_DK, GLA_WIDTH,
    GLA_GATE_RANK, GLA_WIDTH,
    RET_HEADS * RET_DK, RET_HEADS * RET_DK, RET_WIDTH,
    RET_WIDTH,
)
D_IN = sum(IN_SPLITS)

kernel_name = "hybrid_mla_gla_retention_macaron"


def rms_norm(x, g):
    xf = x.astype(jnp.float32)
    y = xf * lax.rsqrt(jnp.mean(xf * xf, axis=-1, keepdims=True) + EPS)
    return (y * g.astype(jnp.float32)).astype(x.dtype)


def swiglu(x, w_gate, w_up, w_down):
    return (jax.nn.silu(x @ w_gate) * (x @ w_up)) @ w_down


def rope_tables(positions):
    inv = ROPE_BASE ** (-jnp.arange(0, ROPE_DIM, 2, dtype=jnp.float32) / ROPE_DIM)
    ang = positions.astype(jnp.float32)[..., None] * inv
    return jnp.cos(ang), jnp.sin(ang)


def apply_rope(x, cos, sin):
    xf = x.astype(jnp.float32)
    x1, x2 = jnp.split(xf, 2, axis=-1)
    c, s = cos[:, :, None, :], sin[:, :, None, :]
    return jnp.concatenate([x1 * c - x2 * s, x1 * s + x2 * c], axis=-1).astype(x.dtype)


def block_causal_attention(q, k, v):
    B, S, H, Dq = q.shape
    Dv = v.shape[-1]
    nb = S // Q_BLOCK
    scale = Dq ** -0.5
    qb = jnp.moveaxis(q.reshape(B, nb, Q_BLOCK, H, Dq), 1, 0)
    q_chunk = (jnp.arange(S) // CHUNK).reshape(nb, Q_BLOCK)
    k_chunk = jnp.arange(S) // CHUNK

    def one_block(args):
        q_blk, qc = args
        s = jnp.einsum('bqhd,bkhd->bhqk', q_blk, k,
                       preferred_element_type=jnp.float32) * scale
        mask = k_chunk[None, :] <= qc[:, None]
        s = jnp.where(mask, s, jnp.finfo(jnp.float32).min)
        p = jax.nn.softmax(s, axis=-1).astype(v.dtype)
        return jnp.einsum('bhqk,bkhe->bqhe', p, v)

    out = lax.map(one_block, (qb, q_chunk))
    return jnp.moveaxis(out, 0, 1).reshape(B, S, H, Dv)


def chunk_state_scan(d_state, decay):
    def step(s, inp):
        ds, dec = inp
        return dec * s + ds, s
    s0 = jnp.zeros_like(d_state[:, 0])
    _, s_before = lax.scan(step, s0, (jnp.moveaxis(d_state, 1, 0), jnp.moveaxis(decay, 1, 0)))
    return jnp.moveaxis(s_before, 0, 1)


def gla_chunked(q, k, v, log_a):
    B, S, H, DK = q.shape
    DV = v.shape[-1]
    N, L = S // CHUNK, CHUNK
    r = lambda t: t.reshape(B, N, L, H, t.shape[-1]).astype(jnp.float32)
    q, k, v, g = r(q), r(k), r(v), r(log_a)
    b = jnp.cumsum(g, axis=2)
    b_last = b[:, :, -1]
    eb, enb = jnp.exp(b), jnp.exp(-b)
    q_fwd, k_fwd = q * eb, k * enb
    a_low = jnp.einsum('bnihd,bnjhd->bnhij', q_fwd, k_fwd)
    a_up = jnp.einsum('bnihd,bnjhd->bnhij', q * enb, k * eb)
    lower = jnp.tril(jnp.ones((L, L), dtype=bool))
    attn = jnp.where(lower, a_low, a_up)
    o_intra = jnp.einsum('bnhij,bnjhe->bnihe', attn, v)
    k_state = k * jnp.exp(b_last[:, :, None] - b)
    d_state = jnp.einsum('bnjhd,bnjhe->bnhde', k_state, v)
    s_before = chunk_state_scan(d_state, jnp.exp(b_last)[..., None])
    o_inter = jnp.einsum('bnihd,bnhde->bnihe', q_fwd, s_before)
    return (o_intra + o_inter).reshape(B, S, H, DV)


def retention_chunked(q, k, v):
    B, S, H, DK = q.shape
    DV = v.shape[-1]
    N, L = S // CHUNK, CHUNK
    r = lambda t: t.reshape(B, N, L, H, t.shape[-1]).astype(jnp.float32)
    q, k, v = r(q), r(k), r(v)
    log_gamma = jnp.log1p(-jnp.exp2(-5.0 - jnp.arange(H, dtype=jnp.float32)))
    idx = jnp.arange(L, dtype=jnp.float32)
    dist = jnp.abs(idx[:, None] - idx[None, :])
    decay_mat = jnp.exp(log_gamma[:, None, None] * dist)
    scores = jnp.einsum('bnihd,bnjhd->bnhij', q, k) * decay_mat
    o_intra = jnp.einsum('bnhij,bnjhe->bnihe', scores, v)
    q_dec = jnp.exp(log_gamma[None, :] * (idx[:, None] + 1.0))
    k_dec = jnp.exp(log_gamma[None, :] * (L - 1.0 - idx[:, None]))
    d_state = jnp.einsum('bnjhd,bnjhe,jh->bnhde', k, v, k_dec)
    chunk_dec = jnp.broadcast_to(jnp.exp(log_gamma * L)[None, None, :, None, None], (1, N, H, 1, 1))
    s_before = chunk_state_scan(d_state, chunk_dec)
    o_inter = jnp.einsum('bnihd,bnhde,ih->bnihe', q, s_before, q_dec)
    return (o_intra + o_inter).reshape(B, S, H, DV)


def hybrid_mixer(h, cos, sin, w_in, mla_q_norm_g, mla_w_q_up, mla_kv_norm_g, mla_w_kv_up,
                 gla_w_gate_up, gla_b_gate, gla_norm_g, ret_norm_g, w_out):
    B, S, _ = h.shape
    offsets = np.cumsum(IN_SPLITS)[:-1].tolist()
    (mq, mkv, mkr, gq, gk, gv, gg, gr, rq, rk, rv, rg) = jnp.split(h @ w_in, offsets, axis=-1)

    qh = (rms_norm(mq, mla_q_norm_g) @ mla_w_q_up).reshape(B, S, MLA_HEADS, MLA_NOPE + MLA_ROPE)
    q_pe = apply_rope(qh[..., MLA_NOPE:], cos, sin)
    kvh = (rms_norm(mkv, mla_kv_norm_g) @ mla_w_kv_up).reshape(B, S, MLA_HEADS, MLA_NOPE + MLA_V)
    k_pe = apply_rope(mkr[:, :, None, :], cos, sin)
    q_mla = jnp.concatenate([qh[..., :MLA_NOPE], q_pe], axis=-1)
    k_mla = jnp.concatenate([kvh[..., :MLA_NOPE],
                             jnp.broadcast_to(k_pe, (B, S, MLA_HEADS, MLA_ROPE))], axis=-1)
    o_mla = block_causal_attention(q_mla, k_mla, kvh[..., MLA_NOPE:]).reshape(B, S, MLA_WIDTH)

    g_q = gq.reshape(B, S, GLA_HEADS, GLA_DK) * (GLA_DK ** -0.5)
    g_k = gk.reshape(B, S, GLA_HEADS, GLA_DK)
    g_v = gv.reshape(B, S, GLA_HEADS, GLA_DV)
    log_a = jax.nn.log_sigmoid((gg @ gla_w_gate_up + gla_b_gate).astype(jnp.float32)) / GLA_TAU
    o_g = gla_chunked(g_q, g_k, g_v, log_a.reshape(B, S, GLA_HEADS, GLA_DK)).astype(h.dtype)
    o_gla = (rms_norm(o_g, gla_norm_g) * jax.nn.silu(gr.reshape(B, S, GLA_HEADS, GLA_DV))
             ).reshape(B, S, GLA_WIDTH)

    r_q = apply_rope(rq.reshape(B, S, RET_HEADS, RET_DK), cos, sin)
    r_k = apply_rope(rk.reshape(B, S, RET_HEADS, RET_DK), cos, sin) * (RET_DK ** -0.5)
    o_r = retention_chunked(r_q, r_k, rv.reshape(B, S, RET_HEADS, RET_DV)).astype(h.dtype)
    o_ret = (rms_norm(o_r, ret_norm_g) * jax.nn.silu(rg.reshape(B, S, RET_HEADS, RET_DV))
             ).reshape(B, S, RET_WIDTH)

    return jnp.concatenate([o_mla, o_gla, o_ret], axis=-1) @ w_out


def setup_inputs(seed: int = 0) -> dict:
    key = jax.random.key(seed)
    ks = jax.random.split(key, 24)
    f32 = jnp.float32
    nrm = lambda k, shape, fan_in: jax.random.normal(k, shape, f32) * (fan_in ** -0.5)
    gain = lambda k, n: 1.0 + 0.02 * jax.random.normal(k, (DEPTH, n), f32)
    x = jax.random.normal(ks[0], (BATCH, SEQ, D_MODEL), f32)
    offset = jax.random.randint(ks[1], (BATCH, 1), 0, SEQ, dtype=jnp.int32)
    positions = offset + jnp.arange(SEQ, dtype=jnp.int32)[None, :]
    return {
        "x": x,
        "positions": positions,
        "ffn1_pre_g": gain(ks[2], D_MODEL),
        "ffn1_post_g": gain(ks[3], D_MODEL),
        "ffn1_w_gate": nrm(ks[4], (DEPTH, D_MODEL, D_FF), D_MODEL),
        "ffn1_w_up": nrm(ks[5], (DEPTH, D_MODEL, D_FF), D_MODEL),
        "ffn1_w_down": nrm(ks[6], (DEPTH, D_FF, D_MODEL), D_FF),
        "mix_pre_g": gain(ks[7], D_MODEL),
        "mix_post_g": gain(ks[8], D_MODEL),
        "w_in": nrm(ks[9], (DEPTH, D_MODEL, D_IN), D_MODEL),
        "mla_q_norm_g": gain(ks[10], MLA_Q_RANK),
        "mla_w_q_up": nrm(ks[11], (DEPTH, MLA_Q_RANK, MLA_HEADS * (MLA_NOPE + MLA_ROPE)), MLA_Q_RANK),
        "mla_kv_norm_g": gain(ks[12], MLA_KV_RANK),
        "mla_w_kv_up": nrm(ks[13], (DEPTH, MLA_KV_RANK, MLA_HEADS * (MLA_NOPE + MLA_V)), MLA_KV_RANK),
        "gla_w_gate_up": nrm(ks[14], (DEPTH, GLA_GATE_RANK, GLA_HEADS * GLA_DK), GLA_GATE_RANK),
        "gla_b_gate": 0.1 * jax.random.normal(ks[15], (DEPTH, GLA_HEADS * GLA_DK), f32),
        "gla_norm_g": gain(ks[16], GLA_DV),
        "ret_norm_g": gain(ks[17], RET_DV),
        "w_out": nrm(ks[18], (DEPTH, MIX_WIDTH, D_MODEL), MIX_WIDTH),
        "ffn2_pre_g": gain(ks[19], D_MODEL),
        "ffn2_post_g": gain(ks[20], D_MODEL),
        "ffn2_w_gate": nrm(ks[21], (DEPTH, D_MODEL, D_FF), D_MODEL),
        "ffn2_w_up": nrm(ks[22], (DEPTH, D_MODEL, D_FF), D_MODEL),
        "ffn2_w_down": nrm(ks[23], (DEPTH, D_FF, D_MODEL), D_FF),
    }


def reference(x, positions, ffn1_pre_g, ffn1_post_g, ffn1_w_gate, ffn1_w_up, ffn1_w_down,
              mix_pre_g, mix_post_g, w_in, mla_q_norm_g, mla_w_q_up, mla_kv_norm_g, mla_w_kv_up,
              gla_w_gate_up, gla_b_gate, gla_norm_g, ret_norm_g, w_out,
              ffn2_pre_g, ffn2_post_g, ffn2_w_gate, ffn2_w_up, ffn2_w_down):
    cos, sin = rope_tables(positions)
    for l in range(DEPTH):
        f = swiglu(rms_norm(x, ffn1_pre_g[l]), ffn1_w_gate[l], ffn1_w_up[l], ffn1_w_down[l])
        x = x + 0.5 * rms_norm(f, ffn1_post_g[l])
        m = hybrid_mixer(rms_norm(x, mix_pre_g[l]), cos, sin, w_in[l],
                         mla_q_norm_g[l], mla_w_q_up[l], mla_kv_norm_g[l], mla_w_kv_up[l],
                         gla_w_gate_up[l], gla_b_gate[l], gla_norm_g[l], ret_norm_g[l], w_out[l])
        x = x + rms_norm(m, mix_post_g[l])
        f = swiglu(rms_norm(x, ffn2_pre_g[l]), ffn2_w_gate[l], ffn2_w_up[l], ffn2_w_down[l])
        x = x + 0.5 * rms_norm(f, ffn2_post_g[l])
    return x
```

```cpp
#include <hip/hip_runtime.h>
#include <hip/hip_cooperative_groups.h>
#include <cstdio>
#include <cstdint>
namespace cg = cooperative_groups;

#ifndef PROBE_ATTN
#define PROBE_ATTN 0
#endif
#ifndef PROBE_GU
#define PROBE_GU 0
#endif
#ifndef PROBE_DOWN
#define PROBE_DOWN 0
#endif
#ifndef PROBE_CHUNK
#define PROBE_CHUNK 0
#endif
#ifndef PROBE_SMALL
#define PROBE_SMALL 0
#endif
#ifndef MK_ONE_LAUNCH
#define MK_ONE_LAUNCH 1
#endif

typedef unsigned short bf16_t;
typedef short bf16x8 __attribute__((ext_vector_type(8)));
typedef float f32x4 __attribute__((ext_vector_type(4)));
typedef float f32x16 __attribute__((ext_vector_type(16)));
typedef unsigned u32x4 __attribute__((ext_vector_type(4)));
typedef unsigned u32x2 __attribute__((ext_vector_type(2)));
typedef short v4i16_t __attribute__((ext_vector_type(4)));
#define LAS __attribute__((address_space(3)))
typedef float f32x2_t __attribute__((ext_vector_type(2)));
typedef __bf16 bf16x2_t __attribute__((ext_vector_type(2)));

__device__ __forceinline__ unsigned cvtpk(float lo, float hi) { f32x2_t v = {lo, hi}; bf16x2_t b = __builtin_convertvector(v, bf16x2_t); return __builtin_bit_cast(unsigned, b); }
__device__ __forceinline__ float bflo(unsigned w) { return __uint_as_float(w << 16); }
__device__ __forceinline__ float bfhi(unsigned w) { return __uint_as_float(w & 0xffff0000u); }
template <int X> __device__ __forceinline__ float swz_xor(float v) { return __int_as_float(__builtin_amdgcn_ds_swizzle(__float_as_int(v), (X << 10) | 0x1F)); }
__device__ __forceinline__ float wave_sum(float v) {
    v += swz_xor<1>(v); v += swz_xor<2>(v); v += swz_xor<4>(v); v += swz_xor<8>(v); v += swz_xor<16>(v);
    auto r = __builtin_amdgcn_permlane32_swap(__float_as_uint(v), __float_as_uint(v), false, false); return __uint_as_float(r[0]) + __uint_as_float(r[1]);
}

__device__ __forceinline__ float add_xor16(float v) { return v + __int_as_float(__builtin_amdgcn_ds_swizzle(__float_as_int(v), 0x401F)); }
__device__ __forceinline__ float add_xor32(float v) { auto r = __builtin_amdgcn_permlane32_swap(__float_as_uint(v), __float_as_uint(v), false, false); return __uint_as_float(r[0]) + __uint_as_float(r[1]); }

__device__ __forceinline__ int fresh_tid(int wave_s) { unsigned z = 0; asm volatile("" : "+v"(z)); return wave_s * 64 + (int)__builtin_amdgcn_mbcnt_hi(~0u, __builtin_amdgcn_mbcnt_lo(~0u, z)); }

constexpr int T = 32768, SEQ = 4096, D = 1024, FF = 2816, DINP = 2048, DIN = 1968;
constexpr int C_MQ = 0, C_MKV = 256, C_MKR = 384, C_GQ = 416, C_GK = 544, C_GV = 672, C_GG = 928, C_GR = 944, C_RQ = 1200, C_RK = 1328, C_RV = 1456, C_RG = 1712;
constexpr float EPS = 1e-6f;
constexpr float QSCALE = 0.10206207261596577f * 1.4426950408889634f;

namespace pg8 {
#define PG8_LAS __attribute__((address_space(3)))
constexpr int BM = 256, BK = 64, HALF = 128, HTB = HALF * BK * 2, STAGE_BYTES = 8 * HTB, NXCD = 8, WGM = 8;

__host__ __device__ __forceinline__ int lds_byte(int r, int c) { const int st = (r >> 4) * 2 + (c >> 5), rr = r & 15, cc = c & 31, ob = rr * 64 + cc * 2; return st * 1024 + (ob ^ (((ob >> 9) & 1) << 5)); }
__host__ __device__ __forceinline__ void stage_rc(int b, int& R, int& C) { const int st = b / 1024, sb = b % 1024, swz = sb ^ (((sb >> 9) & 1) << 5); R = (st >> 1) * 16 + swz / 64; C = (st & 1) * 32 + (swz % 64) / 2; }
__host__ __device__ __forceinline__ int perm32(int rho) { const int n = rho >> 4, i = rho & 15; return 8 * (i >> 2) + 4 * n + (i & 3); }

struct Unit { int pm, pn; };
struct Gemm { const bf16_t* A; const bf16_t* Bt; int M, N, K, lda; };

struct StaticOrder {
    int nM, nN, nwg, G, c;
    __host__ __device__ void init(int M, int N, int G_, int c_) { nM = M / BM; nN = N / BM; nwg = nM * nN; G = G_; c = c_; }
    __host__ __device__ bool next(int i, Unit& u) const {
        const long L = (long)i * G + c; if (L >= nwg) return false;
        int wgid = (int)L; { const int q = nwg / NXCD, r = nwg % NXCD, xcd = wgid % NXCD, off = wgid / NXCD; wgid = (xcd < r ? xcd * (q + 1) : r * (q + 1) + (xcd - r) * q) + off; }
        const int nig = WGM * nN, gid = wgid / nig, fm = gid * WGM, gsz = (nM - fm) < WGM ? (nM - fm) : WGM;
        u.pm = fm + ((wgid % nig) % gsz); u.pn = (wgid % nig) / gsz; return true;
    }
};


__device__ __forceinline__ float silu_f(float g) { return g * __builtin_amdgcn_rcpf(1.0f + __expf(-g)); }

struct EpiSwiglu {
    bf16_t* O; int ldc; const float* rr;
    __device__ __forceinline__ void prefetch(const Unit& u, int wr, int fr, float (&pre)[8]) const {
#pragma unroll
        for (int i = 0; i < 8; ++i) pre[i] = rr[u.pm * BM + wr * 64 + fr + (i >> 2) * HALF + (i & 3) * 16];
    }
    __device__ __forceinline__ void operator()(const f32x4 (&acc)[2][2][4][2], const Unit& u, int wr, int wc, int fr, int fq, const float (&pre)[8]) const {
        const int row0 = u.pm * BM + wr * 64 + fr; const int col0 = u.pn * 128 + wc * 32 + 8 * fq;
#pragma unroll
        for (int ai = 0; ai < 2; ++ai)
#pragma unroll
            for (int m = 0; m < 4; ++m) {
                bf16_t* rowp = O + (size_t)(row0 + ai * HALF + m * 16) * ldc + col0;
                const float rs = pre[ai * 4 + m];
                const f32x4 g0 = acc[ai][0][m][0] * rs, g1 = acc[ai][0][m][1] * rs, u0 = acc[ai][1][m][0] * rs, u1 = acc[ai][1][m][1] * rs;
                u32x4 w;
                w.x = cvtpk(silu_f(g0[0]) * u0[0], silu_f(g0[1]) * u0[1]); w.y = cvtpk(silu_f(g0[2]) * u0[2], silu_f(g0[3]) * u0[3]);
                w.z = cvtpk(silu_f(g1[0]) * u1[0], silu_f(g1[1]) * u1[1]); w.w = cvtpk(silu_f(g1[2]) * u1[2], silu_f(g1[3]) * u1[3]);
                *(u32x4*)rowp = w;
            }
    }
};

struct EpiPlain {
    bf16_t* O; int ldc; float* ssq; float* sskv; const float* rr;
    __device__ __forceinline__ void prefetch(const Unit& u, int wr, int fr, float (&pre)[8]) const {
#pragma unroll
        for (int i = 0; i < 8; ++i) pre[i] = rr ? rr[u.pm * BM + wr * 64 + fr + (i >> 2) * HALF + (i & 3) * 16] : 1.0f;
    }
    __device__ __forceinline__ void operator()(const f32x4 (&acc)[2][2][4][2], const Unit& u, int wr, int wc, int fr, int fq, const float (&pre)[8]) const {
        const int row0 = u.pm * BM + wr * 64 + fr; const int col0 = u.pn * BM + wc * 32 + 8 * fq;
        const bool do_q = (ssq != nullptr) && (u.pn == 0), do_kv = (ssq != nullptr) && (u.pn == 1);
#pragma unroll
        for (int ai = 0; ai < 2; ++ai)
#pragma unroll
            for (int m = 0; m < 4; ++m) {
                const int row = row0 + ai * HALF + m * 16;
                bf16_t* rowp = O + (size_t)row * ldc + col0;
                const float rs = pre[ai * 4 + m];
#pragma unroll
                for (int bj = 0; bj < 2; ++bj) {
                    const f32x4 v0 = acc[ai][bj][m][0] * rs, v1 = acc[ai][bj][m][1] * rs;
                    u32x4 w; w.x = cvtpk(v0[0], v0[1]); w.y = cvtpk(v0[2], v0[3]); w.z = cvtpk(v1[0], v1[1]); w.w = cvtpk(v1[2], v1[3]);
                    *(u32x4*)(rowp + bj * HALF) = w;
                    if (do_q || (do_kv && bj == 0)) {
                        float s = (v0[0] * v0[0] + v0[1] * v0[1]) + (v0[2] * v0[2] + v0[3] * v0[3]) + (v1[0] * v1[0] + v1[1] * v1[1]) + (v1[2] * v1[2] + v1[3] * v1[3]);
                        s = add_xor16(s); s = add_xor32(s);
                        if (fq == 0) { if (do_q) ssq[(size_t)row * 8 + bj * 4 + wc] = s; else sskv[(size_t)row * 4 + wc] = s; }
                    }
                }
            }
    }
};

struct EpiQ {
    bf16_t* Q; const float* ssq; const float* cs; const float* sn;
    __device__ __forceinline__ void prefetch(const Unit&, int, int, float (&pre)[8]) const {
#pragma unroll
        for (int i = 0; i < 8; ++i) pre[i] = 0.f; }
    __device__ __forceinline__ void operator()(const f32x4 (&acc)[2][2][4][2], const Unit& u, int wr, int wc, int fr, int fq, const float (&)[8]) const {
        const int row0 = u.pm * BM + wr * 64 + fr; const int col0 = u.pn * BM + wc * 32 + 8 * fq;
        const int dd = 8 * (fq & 1);
#pragma unroll
        for (int ai = 0; ai < 2; ++ai)
#pragma unroll
            for (int m = 0; m < 4; ++m) {
                const int row = row0 + ai * HALF + m * 16;
                const f32x4 s0 = *(const f32x4*)(ssq + (size_t)row * 8), s1 = *(const f32x4*)(ssq + (size_t)row * 8 + 4);
                const float tot = ((s0[0] + s0[1]) + (s0[2] + s0[3])) + ((s1[0] + s1[1]) + (s1[2] + s1[3]));
                const float sc = rsqrtf(tot * (1.0f / 256.0f) + EPS) * QSCALE;
                bf16_t* rowp = Q + (size_t)row * 768 + col0;
#pragma unroll
                for (int bj = 0; bj < 2; ++bj) {
                    f32x4 v0 = acc[ai][bj][m][0] * sc, v1 = acc[ai][bj][m][1] * sc;
                    const int G = 8 * u.pn + 4 * bj + wc;
                    if ((G % 3) == 2) {
                        const f32x4 c0 = *(const f32x4*)(cs + (size_t)row * 16 + dd), c1 = *(const f32x4*)(cs + (size_t)row * 16 + dd + 4);
                        const f32x4 n0 = *(const f32x4*)(sn + (size_t)row * 16 + dd), n1 = *(const f32x4*)(sn + (size_t)row * 16 + dd + 4);
                        f32x4 p0, p1;
#pragma unroll
                        for (int j = 0; j < 4; ++j) { const int pl = ((16 * fq + fr) ^ 32) * 4; p0[j] = __int_as_float(__builtin_amdgcn_ds_bpermute(pl, __float_as_int(v0[j]))); p1[j] = __int_as_float(__builtin_amdgcn_ds_bpermute(pl, __float_as_int(v1[j]))); }
                        if (fq < 2) { v0 = v0 * c0 - p0 * n0; v1 = v1 * c1 - p1 * n1; }
                        else        { v0 = p0 * n0 + v0 * c0; v1 = p1 * n1 + v1 * c1; }
                    }
                    u32x4 w; w.x = cvtpk(v0[0], v0[1]); w.y = cvtpk(v0[2], v0[3]); w.z = cvtpk(v1[0], v1[1]); w.w = cvtpk(v1[2], v1[3]);
                    *(u32x4*)(rowp + bj * HALF) = w;
                }
                if (m & 1) asm volatile("" ::: "memory");
            }
    }
};

struct EpiKV {
    bf16_t* Kb; bf16_t* Vb; const float* sskv; const bf16_t* proj; const float* cs; const float* sn;
    __device__ __forceinline__ void prefetch(const Unit&, int, int, float (&pre)[8]) const {
#pragma unroll
        for (int i = 0; i < 8; ++i) pre[i] = 0.f; }
    __device__ __forceinline__ void operator()(const f32x4 (&acc)[2][2][4][2], const Unit& u, int wr, int wc, int fr, int fq, const float (&)[8]) const {
        const int row0 = u.pm * BM + wr * 64 + fr;
#pragma unroll
        for (int ai = 0; ai < 2; ++ai)
#pragma unroll
            for (int m = 0; m < 4; ++m) {
                const int row = row0 + ai * HALF + m * 16;
                const f32x4 s0 = *(const f32x4*)(sskv + (size_t)row * 4);
                const float sc = rsqrtf(((s0[0] + s0[1]) + (s0[2] + s0[3])) * (1.0f / 128.0f) + EPS);
#pragma unroll
                for (int bj = 0; bj < 2; ++bj) {
                    const f32x4 v0 = acc[ai][bj][m][0] * sc, v1 = acc[ai][bj][m][1] * sc;
                    u32x4 w; w.x = cvtpk(v0[0], v0[1]); w.y = cvtpk(v0[2], v0[3]); w.z = cvtpk(v1[0], v1[1]); w.w = cvtpk(v1[2], v1[3]);
                    const int head = 2 * u.pn + bj;
                    if (wc < 2) *(u32x4*)(Kb + (size_t)row * 768 + head * 96 + wc * 32 + 8 * fq) = w;
                    else        *(u32x4*)(Vb + (size_t)row * 512 + head * 64 + (wc - 2) * 32 + 8 * fq) = w;
                }
                if (wc < 2) {
                    const u32x2 a = *(const u32x2*)(proj + (size_t)row * DINP + C_MKR + 4 * fq), b = *(const u32x2*)(proj + (size_t)row * DINP + C_MKR + 16 + 4 * fq);
                    const f32x4 c = *(const f32x4*)(cs + (size_t)row * 16 + 4 * fq), s = *(const f32x4*)(sn + (size_t)row * 16 + 4 * fq);
                    const f32x4 x1 = {bflo(a.x), bfhi(a.x), bflo(a.y), bfhi(a.y)}, x2 = {bflo(b.x), bfhi(b.x), bflo(b.y), bfhi(b.y)};
                    const f32x4 o = (wc == 0) ? (x1 * c - x2 * s) : (x1 * s + x2 * c);
                    u32x2 w; w.x = cvtpk(o[0], o[1]); w.y = cvtpk(o[2], o[3]);
#pragma unroll
                    for (int bj = 0; bj < 2; ++bj) *(u32x2*)(Kb + (size_t)row * 768 + (2 * u.pn + bj) * 96 + 64 + wc * 16 + 4 * fq) = w;
                }
                if (m & 1) asm volatile("" ::: "memory");
            }
    }
};

struct EpiRes {
    bf16_t* xb; float* xf32; const float* post_g; float scale; float* xch; unsigned* cnt; float* rr;
    __device__ __forceinline__ void prefetch(const Unit&, int, int, float (&pre)[8]) const {
#pragma unroll
        for (int i = 0; i < 8; ++i) pre[i] = 0.f; }
    __device__ __forceinline__ void operator()(const f32x4 (&acc)[2][2][4][2], const Unit& u, int wr, int wc, int fr, int fq, const float (&)[8]) const {
        int zl_ = 0; asm volatile("" : "+v"(zl_));
        LAS float* P = (LAS float*)(132096 + zl_);
        LAS float* S = P + 1024;
        float* xnp = xch + 4 * 65536;
        const int wid = wr * 4 + wc, lane = fq * 16 + fr, tid = wid * 64 + lane;
#define ER_BAR() do { asm volatile("s_waitcnt lgkmcnt(0)" ::: "memory"); __builtin_amdgcn_s_barrier(); asm volatile("" ::: "memory"); } while (0)
        const int col0 = u.pn * BM + wc * 32 + 8 * fq;
        u32x4 xw[2][4][2]; f32x4 gg[2][2];
#pragma unroll
        for (int ai = 0; ai < 2; ++ai)
#pragma unroll
            for (int m = 0; m < 4; ++m)
#pragma unroll
                for (int bj = 0; bj < 2; ++bj) xw[ai][m][bj] = *(const u32x4*)(xb + (size_t)(u.pm * BM + ai * HALF + wr * 64 + m * 16 + fr) * 1024 + col0 + bj * HALF);
#pragma unroll
        for (int bj = 0; bj < 2; ++bj) { gg[bj][0] = *(const f32x4*)(post_g + col0 + bj * HALF); gg[bj][1] = *(const f32x4*)(post_g + col0 + bj * HALF + 4); }
#pragma unroll
        for (int ai = 0; ai < 2; ++ai)
#pragma unroll
            for (int m = 0; m < 4; ++m) {
                float sq = 0.f;
#pragma unroll
                for (int bj = 0; bj < 2; ++bj)
#pragma unroll
                    for (int n = 0; n < 2; ++n) { const f32x4 v = acc[ai][bj][m][n]; sq += (v[0] * v[0] + v[1] * v[1]) + (v[2] * v[2] + v[3] * v[3]); }
                sq = add_xor16(sq); sq = add_xor32(sq);
                if (fq == 0) P[(ai * HALF + wr * 64 + m * 16 + fr) * 4 + wc] = sq;
            }
        ER_BAR();
        if (tid < 256) { const float tot = (P[tid * 4] + P[tid * 4 + 1]) + (P[tid * 4 + 2] + P[tid * 4 + 3]);
            __hip_atomic_store((unsigned*)xch + ((size_t)(u.pm * BM + tid) * 4 + u.pn), __float_as_uint(tot), __ATOMIC_RELAXED, __HIP_MEMORY_SCOPE_AGENT); }
        asm volatile("s_waitcnt vmcnt(0)" ::: "memory");
        if (lane == 0) __hip_atomic_fetch_add(cnt + 64 * u.pm, 1u, __ATOMIC_RELAXED, __HIP_MEMORY_SCOPE_AGENT);
        if (wid == 0) {
            unsigned spins = 0;
            while ((unsigned)__builtin_amdgcn_readfirstlane(__hip_atomic_load(cnt + 64 * u.pm, __ATOMIC_RELAXED, __HIP_MEMORY_SCOPE_AGENT)) < 32u) { __builtin_amdgcn_s_sleep(2); if (++spins > (1u << 22)) break; }
            __builtin_amdgcn_fence(__ATOMIC_ACQUIRE, "agent");
        }
        asm volatile("s_waitcnt vmcnt(0)" ::: "memory");
        ER_BAR();
        if (tid < 256) { const unsigned* xs = (const unsigned*)xch + (size_t)(u.pm * BM + tid) * 4; float tot = 0.f;
#pragma unroll
            for (int t = 0; t < 4; ++t) tot += __uint_as_float(__hip_atomic_load(xs + t, __ATOMIC_RELAXED, __HIP_MEMORY_SCOPE_AGENT));
            S[tid] = rsqrtf(tot * (1.0f / 1024.0f) + EPS) * scale; }
        ER_BAR();
#pragma unroll
        for (int ai = 0; ai < 2; ++ai)
#pragma unroll
            for (int m = 0; m < 4; ++m) {
                const int rl = ai * HALF + wr * 64 + m * 16 + fr; const size_t row = (size_t)(u.pm * BM + rl);
                const float rf = S[rl]; float s2 = 0.f;
#pragma unroll
                for (int bj = 0; bj < 2; ++bj) {
                    const u32x4 xq = xw[ai][m][bj];
                    const f32x4 x0 = {bflo(xq.x), bfhi(xq.x), bflo(xq.y), bfhi(xq.y)}, x1 = {bflo(xq.z), bfhi(xq.z), bflo(xq.w), bfhi(xq.w)};
                    const f32x4 v0 = x0 + acc[ai][bj][m][0] * rf * gg[bj][0], v1 = x1 + acc[ai][bj][m][1] * rf * gg[bj][1];
                    s2 += ((v0[0] * v0[0] + v0[1] * v0[1]) + (v0[2] * v0[2] + v0[3] * v0[3])) + ((v1[0] * v1[0] + v1[1] * v1[1]) + (v1[2] * v1[2] + v1[3] * v1[3]));
                    if (xf32) { *(f32x4*)(xf32 + row * 1024 + col0 + bj * HALF) = v0; *(f32x4*)(xf32 + row * 1024 + col0 + bj * HALF + 4) = v1; }
                    else { u32x4 w; w.x = cvtpk(v0[0], v0[1]); w.y = cvtpk(v0[2], v0[3]); w.z = cvtpk(v1[0], v1[1]); w.w = cvtpk(v1[2], v1[3]); *(u32x4*)(xb + row * 1024 + col0 + bj * HALF) = w; }
                }
                s2 = add_xor16(s2); s2 = add_xor32(s2);
                if (fq == 0) P[rl * 4 + wc] = s2;
            }
        ER_BAR();
        if (!xf32) {
            if (tid < 256) __hip_atomic_store((unsigned*)xnp + ((size_t)(u.pm * BM + tid) * 4 + u.pn), __float_as_uint((P[tid * 4] + P[tid * 4 + 1]) + (P[tid * 4 + 2] + P[tid * 4 + 3])), __ATOMIC_RELAXED, __HIP_MEMORY_SCOPE_AGENT);
            asm volatile("s_waitcnt vmcnt(0)" ::: "memory");
            ER_BAR();
            if (tid == 0) { const unsigned old = __hip_atomic_fetch_add(cnt + 6 * 128 * 64 + 64 * u.pm, 1u, __ATOMIC_RELAXED, __HIP_MEMORY_SCOPE_AGENT); __builtin_amdgcn_fence(__ATOMIC_ACQUIRE, "agent"); S[0] = (old == 3u) ? 1.0f : 0.0f; }
            asm volatile("s_waitcnt vmcnt(0)" ::: "memory");
            ER_BAR();
            if (S[0] != 0.0f && tid < 256) { const unsigned* xs = (const unsigned*)xnp + (size_t)(u.pm * BM + tid) * 4; float tot = 0.f;
#pragma unroll
                for (int t = 0; t < 4; ++t) tot += __uint_as_float(__hip_atomic_load(xs + t, __ATOMIC_RELAXED, __HIP_MEMORY_SCOPE_AGENT));
                rr[u.pm * BM + tid] = rsqrtf(tot * (1.0f / 1024.0f) + EPS); }
        }
#undef ER_BAR
    }
};

template <class Epi>
__device__ __forceinline__ void gemm_phase(PG8_LAS unsigned char* lds, const Gemm g, const StaticOrder& S, const Epi& E, const int wave_s) {
    const int tid = fresh_tid(wave_s);
    const int wid = __builtin_amdgcn_readfirstlane(tid >> 6), lane = tid & 63, wr = wid >> 2, wc = wid & 3, fr = lane & 15, fq = lane >> 4;
    int K_ = g.K, lda_ = g.lda; asm volatile("" : "+s"(K_), "+s"(lda_));
    const int K = K_, nt = K / BK, lda = lda_;
    unsigned voffA[2], voffB[2];
#pragma unroll
    for (int i = 0; i < 2; ++i) { int R, C; stage_rc(tid * 16 + i * 8192, R, C); const int Rb = (R & ~31) + perm32(R & 31);
        voffA[i] = (unsigned)(R * lda + C) * 2u; voffB[i] = (unsigned)(Rb * K + C) * 2u; }
    const size_t kstep = (size_t)(BK * 2);
    const size_t hstepA = (size_t)HALF * lda * 2, hstepB = (size_t)HALF * K * 2;
    const size_t tstepA = 2 * hstepA, tstepB = 2 * hstepB;
    const unsigned ldsw = (unsigned)wid * 1024u;
    const int aoff = lds_byte(wr * 64 + fr, fq * 8), boff = lds_byte(wc * 32 + fr, fq * 8);
#define PG8_SA(b, h) (((b) * 2 + (h)) * HTB)
#define PG8_SB(b, h) ((4 + (b) * 2 + (h)) * HTB)
#define PG8_STAGE(bufoff, gbase, voff) do { _Pragma("unroll") for (int _i = 0; _i < 2; ++_i) \
        __builtin_amdgcn_global_load_lds((const unsigned*)((const char*)(gbase) + (voff)[_i]), (PG8_LAS unsigned*)(lds + (bufoff) + ldsw + _i * 8192), 16, 0, 0); } while (0)
#define PG8_LDA(dst, b, h) do { _Pragma("unroll") for (int m = 0; m < 4; ++m) _Pragma("unroll") for (int k = 0; k < 2; ++k) dst[m][k] = *(const PG8_LAS bf16x8*)(lds + PG8_SA(b, h) + aoff + m * 2048 + k * 1024); } while (0)
#define PG8_LDB(dst, b, h) do { _Pragma("unroll") for (int n = 0; n < 2; ++n) _Pragma("unroll") for (int k = 0; k < 2; ++k) dst[n][k] = *(const PG8_LAS bf16x8*)(lds + PG8_SB(b, h) + boff + n * 2048 + k * 1024); } while (0)
#define PG8_MMA(ai, bj, At, Bt) do { __builtin_amdgcn_s_setprio(1); _Pragma("unroll") for (int m = 0; m < 4; ++m) _Pragma("unroll") for (int n = 0; n < 2; ++n) _Pragma("unroll") for (int k = 0; k < 2; ++k) \
        acc[ai][bj][m][n] = __builtin_amdgcn_mfma_f32_16x16x32_bf16(Bt[n][k], At[m][k], acc[ai][bj][m][n], 0, 0, 0); __builtin_amdgcn_s_setprio(0); } while (0)
#define PG8_WAIT_V(n) asm volatile("s_waitcnt vmcnt(" #n ")" ::: "memory")
#define PG8_WAIT_L(n) asm volatile("s_waitcnt lgkmcnt(" #n ")" ::: "memory")
#define PG8_BAR __builtin_amdgcn_s_barrier()
#define PG8_SCHED __builtin_amdgcn_sched_barrier(0)
    Unit cur, nxt; int ui = 0;
    if (!S.next(0, cur)) return;
    f32x4 acc[2][2][4][2];
#pragma unroll
    for (int a = 0; a < 2; ++a)
#pragma unroll
        for (int b = 0; b < 2; ++b)
#pragma unroll
            for (int m = 0; m < 4; ++m)
#pragma unroll
                for (int n = 0; n < 2; ++n) acc[a][b][m][n] = (f32x4){0.f, 0.f, 0.f, 0.f};
    bf16x8 At[4][2], B0[2][2], B1[2][2];
    const char* cA = (const char*)g.A + (size_t)cur.pm * tstepA; const char* cB = (const char*)g.Bt + (size_t)cur.pn * tstepB;
    PG8_STAGE(PG8_SB(0, 0), cB, voffB); PG8_STAGE(PG8_SB(0, 1), cB + hstepB, voffB); PG8_STAGE(PG8_SA(0, 0), cA, voffA); PG8_STAGE(PG8_SA(0, 1), cA + hstepA, voffA);
    if (wr == 1) PG8_BAR;
    PG8_WAIT_V(2); PG8_BAR;
    PG8_STAGE(PG8_SB(1, 0), cB + kstep, voffB); PG8_STAGE(PG8_SA(1, 0), cA + kstep, voffA); PG8_STAGE(PG8_SB(1, 1), cB + hstepB + kstep, voffB);
    PG8_WAIT_V(6); PG8_BAR;
    for (;;) {
        const bool has_next = S.next(ui + 1, nxt);
        const char* nA = has_next ? (const char*)g.A + (size_t)nxt.pm * tstepA : cA; const char* nB = has_next ? (const char*)g.Bt + (size_t)nxt.pn * tstepB : cB;
        float pre[8]; E.prefetch(cur, wr, fr, pre);
        for (int t = 0; t < nt; t += 2) {
            const bool last = (t == nt - 2);
            const char* a1 = cA + (size_t)(t + 1) * kstep;
            const char* a2 = last ? nA : cA + (size_t)(t + 2) * kstep; const char* b2 = last ? nB : cB + (size_t)(t + 2) * kstep;
            const char* a3 = a2 + kstep; const char* b3 = b2 + kstep;
            PG8_LDB(B0, 0, 0); PG8_LDB(B1, 0, 1); PG8_SCHED; PG8_LDA(At, 0, 0); PG8_STAGE(PG8_SA(1, 1), a1 + hstepA, voffA);
            PG8_WAIT_V(8); PG8_WAIT_L(0); PG8_BAR; PG8_MMA(0, 0, At, B0); PG8_MMA(0, 1, At, B1); PG8_BAR; PG8_SCHED;
            PG8_LDA(At, 0, 1); PG8_STAGE(PG8_SB(0, 0), b2, voffB); PG8_STAGE(PG8_SB(0, 1), b2 + hstepB, voffB); PG8_STAGE(PG8_SA(0, 0), a2, voffA);
            PG8_WAIT_V(8); PG8_WAIT_L(0); PG8_BAR; PG8_MMA(1, 0, At, B0); PG8_MMA(1, 1, At, B1); PG8_BAR; PG8_SCHED;
            PG8_LDB(B0, 1, 0); PG8_LDB(B1, 1, 1); PG8_SCHED; PG8_LDA(At, 1, 0); PG8_STAGE(PG8_SA(0, 1), a2 + hstepA, voffA);
            PG8_WAIT_V(8); PG8_WAIT_L(0); PG8_BAR; PG8_MMA(0, 0, At, B0); PG8_MMA(0, 1, At, B1); PG8_BAR; PG8_SCHED;
            PG8_LDA(At, 1, 1); PG8_STAGE(PG8_SB(1, 0), b3, voffB); PG8_STAGE(PG8_SB(1, 1), b3 + hstepB, voffB); PG8_STAGE(PG8_SA(1, 0), a3, voffA);
            PG8_WAIT_V(8); PG8_WAIT_L(0); PG8_BAR; PG8_MMA(1, 0, At, B0); PG8_MMA(1, 1, At, B1); PG8_BAR; PG8_SCHED;
        }
        if (wr == 0) PG8_BAR;
        { const int tl = fresh_tid(wave_s); const int w2 = wave_s, l2 = tl & 63;
          E(acc, cur, w2 >> 2, w2 & 3, l2 & 15, l2 >> 4, pre); }
        if (!has_next) break;
#pragma unroll
        for (int a = 0; a < 2; ++a)
#pragma unroll
            for (int b = 0; b < 2; ++b)
#pragma unroll
                for (int m = 0; m < 4; ++m)
#pragma unroll
                    for (int n = 0; n < 2; ++n) acc[a][b][m][n] = (f32x4){0.f, 0.f, 0.f, 0.f};
        cur = nxt; cA = nA; cB = nB; ++ui;
        if (wr == 1) PG8_BAR;
    }
    PG8_WAIT_V(0);
    PG8_BAR;
#undef PG8_SA
#undef PG8_SB
#undef PG8_STAGE
#undef PG8_LDA
#undef PG8_LDB
#undef PG8_MMA
#undef PG8_WAIT_V
#undef PG8_WAIT_L
#undef PG8_BAR
#undef PG8_SCHED
}
}

constexpr size_t MiB = 1u << 20;
constexpr size_t WS_W = 1 * MiB;
constexpr size_t WL_GU1 = 0, WL_D1 = 11 * MiB, WL_GU2 = 17 * MiB, WL_D2 = 28 * MiB, WL_IN = 34 * MiB, WL_OUT = 38 * MiB, WL_Q = 40 * MiB, WL_KV = 40 * MiB + 512 * 1024, WL_STRIDE = 41 * MiB;
constexpr size_t WS_H = 83 * MiB;
constexpr size_t WS_F = 147 * MiB;
constexpr size_t WS_R = 211 * MiB;
constexpr size_t WS_Q = WS_R + 128 * MiB;
constexpr size_t WS_XB = 387 * MiB;
constexpr size_t WS_DS = 451 * MiB;
constexpr size_t WS_DEC = 483 * MiB;
constexpr size_t WS_CS = 484 * MiB;
constexpr size_t WS_SN = 486 * MiB;
constexpr size_t WS_SSQ = 488 * MiB;
constexpr size_t WS_SSKV = 489 * MiB;
constexpr size_t WS_RR = 489 * MiB + 512 * 1024;
constexpr size_t WS_END = 490 * MiB;
static_assert(WL_OUT + 2 * MiB <= WL_Q && WL_IN + 4 * MiB <= WL_OUT && WL_D2 + 6 * MiB <= WL_IN, "weight map");

constexpr int LDS_BYTES = 147456;
constexpr int BAR_LDS_OFF = 131072 + 256;
constexpr int WG_LDS_OFF = 131072 + 1024;
constexpr size_t WS_CTL = 0;
constexpr int NWAVES = 8;

struct Args { const void* in[24]; float* out; unsigned char* ws; int ph_lo, ph_hi; };

struct Ctx { unsigned char* lds; int tid, lane, wave, G, bid; };

__device__ __forceinline__ void transpose_item(const float* W, int K, int N, bf16_t* WT, int mode, const float* kscale, float* scr, int item, int nblk, int lane) {
    const int kb = item / nblk, nb = item % nblk, k0 = 64 * kb, n0 = 32 * nb;
    const int nn = n0 + (lane & 31);
    float wv[32];
#pragma unroll
    for (int i = 0; i < 32; ++i) { const int kk = 2 * i + (lane >> 5); wv[i] = (nn < N) ? W[(size_t)(k0 + kk) * N + nn] : 0.f; }
#pragma unroll
    for (int i = 0; i < 32; ++i) { const int kk = 2 * i + (lane >> 5); float v = wv[i]; if (kscale) v *= kscale[k0 + kk]; scr[kk * 33 + (lane & 31)] = v; }
    __builtin_amdgcn_s_waitcnt(0); asm volatile("" ::: "memory");
    const int c = lane & 7;
    int drow0 = n0; if (mode == 1) drow0 = (n0 / 128) * 256 + (n0 % 128); else if (mode == 2) drow0 = (n0 / 128) * 256 + 128 + (n0 % 128);
#pragma unroll
    for (int j = 0; j < 4; ++j) { const int n = (lane >> 3) + 8 * j; const float* s = scr + (8 * c) * 33 + n;
        u32x4 o; o.x = cvtpk(s[0 * 33], s[1 * 33]); o.y = cvtpk(s[2 * 33], s[3 * 33]); o.z = cvtpk(s[4 * 33], s[5 * 33]); o.w = cvtpk(s[6 * 33], s[7 * 33]);
        *(u32x4*)(WT + (size_t)(drow0 + n) * K + k0 + 8 * c) = o; }
    __builtin_amdgcn_s_waitcnt(0); asm volatile("" ::: "memory");
}

__device__ __forceinline__ void resnorm_phase(const Ctx& c, const bf16_t* F, const float* xin32, bf16_t* xb, float* xf32, const float* post_g, float scale, float* rr) {
    constexpr int RN = 4;
    const int gw = c.bid * NWAVES + c.wave, NGW = c.G * NWAVES;
    for (int row0 = gw * RN; row0 < T; row0 += NGW * RN) {
        f32x4 xv[RN][4]; u32x2 fw[RN][4];
#pragma unroll
        for (int q = 0; q < RN; ++q)
#pragma unroll
            for (int j = 0; j < 4; ++j) {
                const size_t off = (size_t)(row0 + q) * D + j * 256 + c.lane * 4;
                if (xin32) xv[q][j] = *(const f32x4*)(xin32 + off);
                else { const u32x2 w = *(const u32x2*)(xb + off); xv[q][j] = (f32x4){bflo(w.x), bfhi(w.x), bflo(w.y), bfhi(w.y)}; }
                if (F) fw[q][j] = *(const u32x2*)(F + off);
            }
#pragma unroll
        for (int q = 0; q < RN; ++q) {
            const int row = row0 + q;
            if (F) {
                f32x4 fv[4]; float ss = 0.f;
#pragma unroll
                for (int j = 0; j < 4; ++j) { const u32x2 w = fw[q][j]; fv[j] = (f32x4){bflo(w.x), bfhi(w.x), bflo(w.y), bfhi(w.y)};
                    ss += (fv[j][0] * fv[j][0] + fv[j][1] * fv[j][1]) + (fv[j][2] * fv[j][2] + fv[j][3] * fv[j][3]); }
                const float r = rsqrtf(wave_sum(ss) * (1.0f / D) + EPS) * scale;
#pragma unroll
                for (int j = 0; j < 4; ++j) { const f32x4 g = *(const f32x4*)(post_g + j * 256 + c.lane * 4); xv[q][j] = xv[q][j] + fv[j] * r * g; }
            }
            if (xf32) {
#pragma unroll
                for (int j = 0; j < 4; ++j) *(f32x4*)(xf32 + (size_t)row * D + j * 256 + c.lane * 4) = xv[q][j];
            } else {
#pragma unroll
                for (int j = 0; j < 4; ++j) { const f32x4 o = xv[q][j]; u32x2 w; w.x = cvtpk(o[0], o[1]); w.y = cvtpk(o[2], o[3]); *(u32x2*)(xb + (size_t)row * D + j * 256 + c.lane * 4) = w; }
            }
            if (rr) {
                float ss = 0.f;
#pragma unroll
                for (int j = 0; j < 4; ++j) ss += (xv[q][j][0] * xv[q][j][0] + xv[q][j][1] * xv[q][j][1]) + (xv[q][j][2] * xv[q][j][2] + xv[q][j][3] * xv[q][j][3]);
                const float r = rsqrtf(wave_sum(ss) * (1.0f / D) + EPS);
                if (c.lane == 0) rr[row] = r;
            }
        }
    }
}

constexpr int AT_K = 0, AT_V = 12288, AT_VP = 192, AT_BUF = 12288 + 64 * AT_VP  , AT_WS = 3 * AT_BUF;
__device__ __forceinline__ int crow(int r, int hi) { return (r & 3) + 8 * (r >> 2) + 4 * hi; }
__device__ __forceinline__ float max3f(float a, float b, float c) { float r; asm("v_max3_f32 %0, %1, %2, %3" : "=v"(r) : "v"(a), "v"(b), "v"(c)); return r; }

__device__ __forceinline__ void attn_unit(const Ctx& c, int bh, int qb, const bf16_t* Q, const bf16_t* Kb, const bf16_t* Vb, bf16_t* O) {
    const int tid = c.tid, lane = c.lane, wid = c.wave, r32 = lane & 31, hi = lane >> 5;
    const int b = bh >> 3, h = bh & 7;
    const size_t rowbase = (size_t)b * SEQ;
    const int q0 = qb * 256;
    unsigned char* lds = c.lds;
    const LAS unsigned char* ldsa = (const LAS unsigned char*)c.lds;
    float* wsf = (float*)(lds + AT_WS) + wid * 64;
    bf16x8 qr[6];
    { const bf16_t* qp = Q + (rowbase + q0 + wid * 32 + r32) * 768 + h * 96 + hi * 8;
#pragma unroll
      for (int d0 = 0; d0 < 6; ++d0) qr[d0] = *(const bf16x8*)(qp + d0 * 16); }
    const int NT = 4 * qb + 4, ntw = 4 * qb + (wid >> 1) + 1;
    const int kr0 = tid / 12, kc0 = tid % 12, kr1 = (512 + tid) / 12, kc1 = (512 + tid) % 12;
    const bf16_t* kg0 = Kb + (rowbase + kr0) * 768 + h * 96 + kc0 * 8;
    const bf16_t* kg1 = Kb + (rowbase + kr1) * 768 + h * 96 + kc1 * 8;
    const bf16_t* vg = Vb + (rowbase + (tid >> 3)) * 512 + h * 64 + (tid & 7) * 8;
    const int ks0 = AT_K + kc0 * 1024 + ((kr0 & 48) | ((kr0 ^ kc0) & 15)) * 16, ks1 = AT_K + kc1 * 1024 + ((kr1 & 48) | ((kr1 ^ kc1) & 15)) * 16;
    const int vs0 = AT_V + (tid >> 3) * AT_VP + (tid & 7) * 16;
    const int kx = r32 ^ hi;
    const int vtb = AT_V + (4 * hi + ((lane & 15) >> 2)) * AT_VP + (16 * ((lane >> 4) & 1) + 4 * (lane & 3)) * 2;
    u32x4 k0rA, k1rA, vrA, k0rB, k1rB, vrB;
#define AT_LOAD(t_, S) do { const int tc_ = (t_) < NT ? (t_) : NT - 1; const size_t off_ = (size_t)tc_ * 64; k0r##S = *(const u32x4*)(kg0 + off_ * 768); k1r##S = *(const u32x4*)(kg1 + off_ * 768); vr##S = *(const u32x4*)(vg + off_ * 512); } while (0)
#define AT_STORE(bo_, S) do { unsigned char* lb_ = lds + (bo_); *(u32x4*)(lb_ + ks0) = k0r##S; if (tid < 256) *(u32x4*)(lb_ + ks1) = k1r##S; *(u32x4*)(lb_ + vs0) = vr##S; } while (0)
#define AT_QK(P0, P1, bo_) do { const unsigned char* kb_ = lds + (bo_) + AT_K + hi * 1024 + (r32 & 16) * 16; \
        _Pragma("unroll") for (int d0 = 0; d0 < 6; ++d0) { const unsigned char* kd_ = kb_ + d0 * 2048 + ((kx ^ (2 * d0)) & 15) * 16; const bf16x8 a0_ = *(const bf16x8*)(kd_), a1_ = *(const bf16x8*)(kd_ + 512); \
            if (d0 == 0) { P0 = __builtin_amdgcn_mfma_f32_32x32x16_bf16(a0_, qr[0], f32x16{}, 0, 0, 0); P1 = __builtin_amdgcn_mfma_f32_32x32x16_bf16(a1_, qr[0], f32x16{}, 0, 0, 0); } \
            else { P0 = __builtin_amdgcn_mfma_f32_32x32x16_bf16(a0_, qr[d0], P0, 0, 0, 0); P1 = __builtin_amdgcn_mfma_f32_32x32x16_bf16(a1_, qr[d0], P1, 0, 0, 0); } } } while (0)
#define AT_MAX(C0, C1, tt_) do { \
        asm volatile("s_nop 15\n\ts_nop 2" : "+v"(C0), "+v"(C1));     \
        float ma_ = max3f(C0[0], C0[1], C1[0]), mb_ = max3f(C0[2], C0[3], C1[1]); ma_ = max3f(ma_, C1[2], C1[3]); \
        _Pragma("unroll") for (int r = 4; r < 16; r += 4) { ma_ = max3f(ma_, C0[r], C0[r + 1]); mb_ = max3f(mb_, C0[r + 2], C0[r + 3]); ma_ = max3f(ma_, C1[r], C1[r + 1]); mb_ = max3f(mb_, C1[r + 2], C1[r + 3]); } \
        float mx_ = max3f(ma_, mb_, mb_); \
        { auto sw_ = __builtin_amdgcn_permlane32_swap(__float_as_uint(mx_), __float_as_uint(mx_), false, false); mx_ = max3f(__uint_as_float(sw_[0]), __uint_as_float(sw_[1]), mx_); }     \
        const bool upd_ = ((tt_) == 0) || (mx_ > mrow + 8.0f); \
        if (__any(upd_)) { \
            const float mn_ = upd_ ? mx_ : mrow; \
            const float alpha_ = __builtin_amdgcn_exp2f(mrow - mn_); mrow = mn_; lsum *= alpha_; \
            if (hi == 0) wsf[r32] = alpha_; \
            asm volatile("" ::: "memory"); \
            _Pragma("unroll") for (int r = 0; r < 16; ++r) { const float a_ = wsf[crow(r, hi)]; o[0][r] *= a_; o[1][r] *= a_; } \
            asm volatile("" ::: "memory"); \
        } } while (0)
#define SB_() __builtin_amdgcn_sched_barrier(0)
#define KFR_(d0_, A0, A1) do { const unsigned char* kd_ = kbn_ + (d0_) * 2048 + ((kx ^ (2 * (d0_))) & 15) * 16; A0 = *(const bf16x8*)(kd_); A1 = *(const bf16x8*)(kd_ + 512); } while (0)
#define VFR_(g_, VV) do { const LAS unsigned char* vb_ = ldsa + b0 + vtb + ((g_) & 1) * 64 + ((g_) >> 1) * 16 * AT_VP; \
        const u32x2 lo_ = __builtin_bit_cast(u32x2, __builtin_amdgcn_ds_read_tr16_b64_v4i16((LAS v4i16_t*)(vb_))), hh_ = __builtin_bit_cast(u32x2, __builtin_amdgcn_ds_read_tr16_b64_v4i16((LAS v4i16_t*)(vb_ + 8 * AT_VP))); \
        VV = (u32x4){lo_.x, lo_.y, hh_.x, hh_.y}; } while (0)
#define EX_(P, r) P[r] = __builtin_amdgcn_exp2f(P[r] - mrow)
#define AT_FAST(C0, C1, N0, N1) do { \
        bf16x8 kb0_, kb1_; u32x4 pw0_, pw1_, pw2_, pw3_, va_, vb2_; float ps_ = 0.f; \
        SB_(); \
          \
        KFR_(1, kb0_, kb1_); N0 = __builtin_amdgcn_mfma_f32_32x32x16_bf16(ka0_, qr[0], f32x16{}, 0, 0, 0); EX_(C0, 0); EX_(C0, 1); SB_(); \
        N1 = __builtin_amdgcn_mfma_f32_32x32x16_bf16(ka1_, qr[0], f32x16{}, 0, 0, 0); EX_(C0, 2); EX_(C0, 3); SB_(); \
        KFR_(2, ka0_, ka1_); N0 = __builtin_amdgcn_mfma_f32_32x32x16_bf16(kb0_, qr[1], N0, 0, 0, 0); EX_(C0, 4); EX_(C0, 5); SB_(); \
        N1 = __builtin_amdgcn_mfma_f32_32x32x16_bf16(kb1_, qr[1], N1, 0, 0, 0); EX_(C0, 6); EX_(C0, 7); SB_(); \
        KFR_(3, kb0_, kb1_); N0 = __builtin_amdgcn_mfma_f32_32x32x16_bf16(ka0_, qr[2], N0, 0, 0, 0); EX_(C0, 8); EX_(C0, 9); SB_(); \
        N1 = __builtin_amdgcn_mfma_f32_32x32x16_bf16(ka1_, qr[2], N1, 0, 0, 0); EX_(C0, 10); EX_(C0, 11); SB_(); \
        KFR_(4, ka0_, ka1_); N0 = __builtin_amdgcn_mfma_f32_32x32x16_bf16(kb0_, qr[3], N0, 0, 0, 0); EX_(C0, 12); EX_(C0, 13); SB_(); \
        N1 = __builtin_amdgcn_mfma_f32_32x32x16_bf16(kb1_, qr[3], N1, 0, 0, 0); EX_(C0, 14); EX_(C0, 15); SB_(); \
        KFR_(5, kb0_, kb1_); N0 = __builtin_amdgcn_mfma_f32_32x32x16_bf16(ka0_, qr[4], N0, 0, 0, 0); ps_ += (C0[0] + C0[1]) + (C0[2] + C0[3]); pw0_.x = cvtpk(C0[0], C0[1]); pw0_.y = cvtpk(C0[2], C0[3]); SB_(); \
        N1 = __builtin_amdgcn_mfma_f32_32x32x16_bf16(ka1_, qr[4], N1, 0, 0, 0); ps_ += (C0[4] + C0[5]) + (C0[6] + C0[7]); pw0_.z = cvtpk(C0[4], C0[5]); pw0_.w = cvtpk(C0[6], C0[7]); SB_(); \
        VFR_(0, va_); N0 = __builtin_amdgcn_mfma_f32_32x32x16_bf16(kb0_, qr[5], N0, 0, 0, 0); ps_ += (C0[8] + C0[9]) + (C0[10] + C0[11]); pw1_.x = cvtpk(C0[8], C0[9]); pw1_.y = cvtpk(C0[10], C0[11]); SB_(); \
        VFR_(1, vb2_); N1 = __builtin_amdgcn_mfma_f32_32x32x16_bf16(kb1_, qr[5], N1, 0, 0, 0); ps_ += (C0[12] + C0[13]) + (C0[14] + C0[15]); pw1_.z = cvtpk(C0[12], C0[13]); pw1_.w = cvtpk(C0[14], C0[15]); SB_(); \
          \
        o[0] = __builtin_amdgcn_mfma_f32_32x32x16_bf16(__builtin_bit_cast(bf16x8, pw0_), __builtin_bit_cast(bf16x8, va_), o[0], 0, 0, 0); VFR_(2, va_); EX_(C1, 0); EX_(C1, 1); EX_(C1, 2); EX_(C1, 3); SB_(); \
        o[1] = __builtin_amdgcn_mfma_f32_32x32x16_bf16(__builtin_bit_cast(bf16x8, pw0_), __builtin_bit_cast(bf16x8, vb2_), o[1], 0, 0, 0); VFR_(3, vb2_); EX_(C1, 4); EX_(C1, 5); EX_(C1, 6); EX_(C1, 7); SB_(); \
        o[0] = __builtin_amdgcn_mfma_f32_32x32x16_bf16(__builtin_bit_cast(bf16x8, pw1_), __builtin_bit_cast(bf16x8, va_), o[0], 0, 0, 0); VFR_(4, va_); EX_(C1, 8); EX_(C1, 9); EX_(C1, 10); EX_(C1, 11); pw2_.x = cvtpk(C1[0], C1[1]); pw2_.y = cvtpk(C1[2], C1[3]); SB_(); \
        o[1] = __builtin_amdgcn_mfma_f32_32x32x16_bf16(__builtin_bit_cast(bf16x8, pw1_), __builtin_bit_cast(bf16x8, vb2_), o[1], 0, 0, 0); VFR_(5, vb2_); EX_(C1, 12); EX_(C1, 13); EX_(C1, 14); EX_(C1, 15); pw2_.z = cvtpk(C1[4], C1[5]); pw2_.w = cvtpk(C1[6], C1[7]); SB_(); \
        o[0] = __builtin_amdgcn_mfma_f32_32x32x16_bf16(__builtin_bit_cast(bf16x8, pw2_), __builtin_bit_cast(bf16x8, va_), o[0], 0, 0, 0); VFR_(6, va_); ps_ += (C1[0] + C1[1]) + (C1[2] + C1[3]); pw3_.x = cvtpk(C1[8], C1[9]); pw3_.y = cvtpk(C1[10], C1[11]); SB_(); \
        o[1] = __builtin_amdgcn_mfma_f32_32x32x16_bf16(__builtin_bit_cast(bf16x8, pw2_), __builtin_bit_cast(bf16x8, vb2_), o[1], 0, 0, 0); VFR_(7, vb2_); ps_ += (C1[4] + C1[5]) + (C1[6] + C1[7]); pw3_.z = cvtpk(C1[12], C1[13]); pw3_.w = cvtpk(C1[14], C1[15]); SB_(); \
        o[0] = __builtin_amdgcn_mfma_f32_32x32x16_bf16(__builtin_bit_cast(bf16x8, pw3_), __builtin_bit_cast(bf16x8, va_), o[0], 0, 0, 0); ps_ += (C1[8] + C1[9]) + (C1[10] + C1[11]); SB_(); \
        o[1] = __builtin_amdgcn_mfma_f32_32x32x16_bf16(__builtin_bit_cast(bf16x8, pw3_), __builtin_bit_cast(bf16x8, vb2_), o[1], 0, 0, 0); ps_ += (C1[12] + C1[13]) + (C1[14] + C1[15]); SB_(); \
        lsum += ps_; } while (0)
#define AT_STEP(C0, C1, N0, N1, t_, S) do { const int tt_ = (t_); \
        AT_STORE(b2, S);                        \
        AT_LOAD(tt_ + 4, S); \
        if (tt_ < ntw) {          \
            kbn_ = lds + b1 + AT_K + hi * 1024 + (r32 & 16) * 16; KFR_(0, ka0_, ka1_);     \
            AT_MAX(C0, C1, tt_); \
            AT_FAST(C0, C1, N0, N1); \
        } \
        asm volatile("s_waitcnt lgkmcnt(0)" ::: "memory"); __builtin_amdgcn_s_barrier(); asm volatile("" ::: "memory");     \
        { const int tb_ = b0; b0 = b1; b1 = b2; b2 = tb_; } } while (0)

    int b0 = 0, b1 = AT_BUF, b2 = 2 * AT_BUF;
    float mrow = -1e30f, lsum = 0.f;
    f32x16 o[2]; o[0] = f32x16{}; o[1] = f32x16{};
    AT_LOAD(0, A); AT_LOAD(1, B); AT_STORE(b0, A); AT_LOAD(2, A); AT_STORE(b1, B); AT_LOAD(3, B);
    __syncthreads();
    f32x16 pA0, pA1, pB0, pB1;
    const unsigned char* kbn_; bf16x8 ka0_, ka1_;
    AT_QK(pA0, pA1, b0);
    for (int t = 0; t < NT; t += 2) {
        AT_STEP(pA0, pA1, pB0, pB1, t, A);
        AT_STEP(pB0, pB1, pA0, pA1, t + 1, B);
    }
#undef AT_LOAD
#undef AT_STORE
#undef AT_QK
#undef AT_FAST
#undef SB_
#undef KFR_
#undef VFR_
#undef EX_
#undef AT_MAX
#undef AT_STEP
    { auto sw_ = __builtin_amdgcn_permlane32_swap(__float_as_uint(lsum), __float_as_uint(lsum), false, false); lsum = __uint_as_float(sw_[0]) + __uint_as_float(sw_[1]); }
    if (hi == 0) wsf[r32] = 1.0f / lsum;
    asm volatile("" ::: "memory");
    bf16_t* op = O + (rowbase + q0 + wid * 32) * 1024 + h * 64 + r32;
#pragma unroll
    for (int r = 0; r < 16; ++r) { const int qq = crow(r, hi); const float rl = wsf[qq];
        op[(size_t)qq * 1024] = (bf16_t)(cvtpk(o[0][r] * rl, 0.f) & 0xffffu); op[(size_t)qq * 1024 + 32] = (bf16_t)(cvtpk(o[1][r] * rl, 0.f) & 0xffffu); }
    asm volatile("" ::: "memory");
}

constexpr int GP = 144;
struct ChunkIn { const bf16_t* proj; const float* wgu; const float* bg; const float* cs; const float* sn; };

struct ChunkRaw { u32x2 qa, qb, ka, kb; u32x4 g0, g1; f32x4 cc, ss; };
template <bool GLA>
__device__ __forceinline__ void chunk_load(const ChunkIn& ci, int t, int h, int kq, ChunkRaw& r) {
    const bf16_t* pr = ci.proj + (size_t)t * DINP;
    const int cq = GLA ? C_GQ : C_RQ, ck = GLA ? C_GK : C_RK;
    r.qa = *(const u32x2*)(pr + cq + h * 32 + 4 * kq); r.qb = *(const u32x2*)(pr + cq + h * 32 + 16 + 4 * kq);
    r.ka = *(const u32x2*)(pr + ck + h * 32 + 4 * kq); r.kb = *(const u32x2*)(pr + ck + h * 32 + 16 + 4 * kq);
    if (GLA) { r.g0 = *(const u32x4*)(pr + C_GG); r.g1 = *(const u32x4*)(pr + C_GG + 8); }
    else { r.cc = *(const f32x4*)(ci.cs + (size_t)t * 16 + 4 * kq); r.ss = *(const f32x4*)(ci.sn + (size_t)t * 16 + 4 * kq); }
}
template <bool GLA>
__device__ __forceinline__ void chunk_tile(const ChunkRaw& raw, const bf16x8 (&wfr)[2], const f32x4 (&bfr)[2], int h, int it, int row, int kq, float lg, float (&carry)[8], float (&bq)[8], float (&qv)[8], float (&kv)[8]) {
    const u32x2 qa = raw.qa, qb = raw.qb, ka = raw.ka, kb = raw.kb;
    float q[8] = {bflo(qa.x), bfhi(qa.x), bflo(qa.y), bfhi(qa.y), bflo(qb.x), bfhi(qb.x), bflo(qb.y), bfhi(qb.y)};
    float k[8] = {bflo(ka.x), bfhi(ka.x), bflo(ka.y), bfhi(ka.y), bflo(kb.x), bfhi(kb.x), bflo(kb.y), bfhi(kb.y)};
    const float qs = 0.17677669529663687f;
    if (GLA) {
        const u32x4 gsel = (kq == 0) ? raw.g0 : (kq == 1) ? raw.g1 : (u32x4){0u, 0u, 0u, 0u};
        const bf16x8 gfr = __builtin_bit_cast(bf16x8, gsel);
        const f32x4 z0 = __builtin_amdgcn_mfma_f32_16x16x32_bf16(wfr[0], gfr, bfr[0], 0, 0, 0), z1 = __builtin_amdgcn_mfma_f32_16x16x32_bf16(wfr[1], gfr, bfr[1], 0, 0, 0);
        const float z[8] = {z0[0], z0[1], z0[2], z0[3], z1[0], z1[1], z1[2], z1[3]};
#pragma unroll
        for (int j = 0; j < 8; ++j) {
            float la = (fminf(z[j], 0.f) - __logf(1.0f + __expf(-fabsf(z[j])))) * (1.0f / 16.0f);
            la += __int_as_float(__builtin_amdgcn_update_dpp(0, __float_as_int(la), 0x111, 0xf, 0xf, false));
            la += __int_as_float(__builtin_amdgcn_update_dpp(0, __float_as_int(la), 0x112, 0xf, 0xf, false));
            la += __int_as_float(__builtin_amdgcn_update_dpp(0, __float_as_int(la), 0x114, 0xf, 0xf, false));
            la += __int_as_float(__builtin_amdgcn_update_dpp(0, __float_as_int(la), 0x118, 0xf, 0xf, false));
            bq[j] = la + carry[j];
            carry[j] += __int_as_float(__builtin_amdgcn_ds_bpermute((16 * kq + 15) * 4, __float_as_int(la)));
            qv[j] = q[j] * qs; kv[j] = k[j];
        }
    } else {
        const f32x4 cc = raw.cc, ss = raw.ss;
#pragma unroll
        for (int j = 0; j < 4; ++j) {
            qv[j] = (q[j] * cc[j] - q[4 + j] * ss[j]) * qs; qv[4 + j] = (q[j] * ss[j] + q[4 + j] * cc[j]) * qs;
            kv[j] = k[j] * cc[j] - k[4 + j] * ss[j];        kv[4 + j] = k[j] * ss[j] + k[4 + j] * cc[j];
        }
#pragma unroll
        for (int j = 0; j < 8; ++j) { bq[j] = (float)(16 * it + row + 1) * lg; carry[j] = 64.0f * lg; }
    }
}

__device__ __forceinline__ void chunk_gate_frags(const float* wgl, int h, int row, int kq, bf16x8 (&wfr)[2], f32x4 (&bfr)[2]) {
#pragma unroll
    for (int nt = 0; nt < 2; ++nt) {
        float w[8];
#pragma unroll
        for (int j = 0; j < 8; ++j) w[j] = (kq < 2) ? wgl[(8 * (kq & 1) + j) * 128 + h * 32 + 16 * nt + row] : 0.f;
        wfr[nt] = __builtin_bit_cast(bf16x8, (u32x4){cvtpk(w[0], w[1]), cvtpk(w[2], w[3]), cvtpk(w[4], w[5]), cvtpk(w[6], w[7])});
        bfr[nt] = *(const f32x4*)(wgl + 2048 + h * 32 + 16 * nt + 4 * kq);
    }
}

__device__ __forceinline__ void chunk_load_vt(const bf16_t* proj, int t0, int vcol, unsigned char* wl, int lane) {
    const bf16_t* vp = proj + (size_t)(t0 + lane) * DINP + vcol;
#pragma unroll
    for (int cidx = 0; cidx < 8; ++cidx) {
        const u32x4 v = *(const u32x4*)(vp + cidx * 8);
        const unsigned w4[4] = {v.x, v.y, v.z, v.w};
#pragma unroll
        for (int j = 0; j < 4; ++j) {
            *(bf16_t*)(wl + (cidx * 8 + 2 * j) * GP + lane * 2) = (bf16_t)(w4[j] & 0xffffu);
            *(bf16_t*)(wl + (cidx * 8 + 2 * j + 1) * GP + lane * 2) = (bf16_t)(w4[j] >> 16);
        }
    }
}

template <bool GLA>
__device__ __forceinline__ void chunk_pass_a(const ChunkIn& ci, const float* wgl, int unit, unsigned char* wl, int lane, float* dS, float* dec) {
    const int h = unit & 3, bn = unit >> 2, t0 = bn * 64;
    const int row = lane & 15, kq = lane >> 4;
    float carry[8] = {0.f, 0.f, 0.f, 0.f, 0.f, 0.f, 0.f, 0.f};
    float bq[4][8], kk[4][8];
    int hh_ = h; asm volatile("" : "+s"(hh_)); const float hf = (float)hh_;
    const float lg = GLA ? 0.f : __logf(1.0f - __builtin_amdgcn_exp2f(-5.0f - hf));
    ChunkRaw raw[4];
#pragma unroll
    for (int it = 0; it < 4; ++it) chunk_load<GLA>(ci, t0 + 16 * it + row, h, kq, raw[it]);
    bf16x8 wfr[2]; f32x4 bfr[2]; if (GLA) chunk_gate_frags(wgl, h, row, kq, wfr, bfr);
#pragma unroll
    for (int it = 0; it < 4; ++it) { float qv[8]; chunk_tile<GLA>(raw[it], wfr, bfr, h, it, row, kq, lg, carry, bq[it], qv, kk[it]); }
    unsigned char* kst = wl + 64 * GP;
#pragma unroll
    for (int it = 0; it < 4; ++it)
#pragma unroll
        for (int j = 0; j < 8; ++j) {
            const int d = (j < 4) ? (4 * kq + j) : (16 + 4 * kq + (j - 4));
            const float ks = kk[it][j] * __expf(carry[j] - bq[it][j]);
            *(bf16_t*)(kst + d * GP + (16 * it + row) * 2) = (bf16_t)(cvtpk(ks, 0.f) & 0xffffu);
        }
    chunk_load_vt(ci.proj, t0, (GLA ? C_GV : C_RV) + h * 64, wl, lane);
    __builtin_amdgcn_s_waitcnt(0); asm volatile("" ::: "memory");
    float* out = dS + (size_t)unit * 2048;
#pragma unroll
    for (int dt = 0; dt < 2; ++dt)
#pragma unroll
        for (int et = 0; et < 4; ++et) {
            f32x4 acc = {0.f, 0.f, 0.f, 0.f};
#pragma unroll
            for (int ks = 0; ks < 2; ++ks) {
                const bf16x8 a = *(const bf16x8*)(kst + (16 * dt + row) * GP + (32 * ks + 8 * kq) * 2);
                const bf16x8 bb = *(const bf16x8*)(wl + (16 * et + row) * GP + (32 * ks + 8 * kq) * 2);
                acc = __builtin_amdgcn_mfma_f32_16x16x32_bf16(a, bb, acc, 0, 0, 0);
            }
#pragma unroll
            for (int r = 0; r < 4; ++r) out[(16 * dt + 4 * kq + r) * 64 + 16 * et + row] = acc[r];
        }
    if (row == 0) {
#pragma unroll
        for (int j = 0; j < 8; ++j) { const int d = (j < 4) ? (4 * kq + j) : (16 + 4 * kq + (j - 4)); dec[(size_t)unit * 32 + d] = __expf(carry[j]); }
    }
    __builtin_amdgcn_s_waitcnt(0); asm volatile("" ::: "memory");
}

template <bool GLA>
__device__ __forceinline__ void chunk_pass_c(const ChunkIn& ci, const float* wgl, int unit, unsigned char* wl, int lane, const float* Sb, const float* ng, bf16_t* omix) {
    const int h = unit & 3, bn = unit >> 2, t0 = bn * 64;
    const int row = lane & 15, kq = lane >> 4;
    chunk_load_vt(ci.proj, t0, (GLA ? C_GV : C_RV) + h * 64, wl, lane);
    unsigned char* sst = wl + 64 * GP;
    { const float* sp = Sb + (size_t)unit * 2048 + lane;
      float sv[32];
#pragma unroll
      for (int d = 0; d < 32; ++d) sv[d] = sp[d * 64];
#pragma unroll
      for (int q4 = 0; q4 < 4; ++q4) {
          u32x4 w; w.x = cvtpk(sv[4 * q4 + 0], sv[4 * q4 + 1]); w.y = cvtpk(sv[4 * q4 + 2], sv[4 * q4 + 3]); w.z = cvtpk(sv[16 + 4 * q4 + 0], sv[16 + 4 * q4 + 1]); w.w = cvtpk(sv[16 + 4 * q4 + 2], sv[16 + 4 * q4 + 3]);
          *(u32x4*)(sst + lane * 64 + q4 * 16) = w;
      } }
    asm volatile("" ::: "memory");
    float carry[8] = {0.f, 0.f, 0.f, 0.f, 0.f, 0.f, 0.f, 0.f};
    int hh_ = h; asm volatile("" : "+s"(hh_)); const float hf = (float)hh_;
    const float lg = GLA ? 0.f : __logf(1.0f - __builtin_amdgcn_exp2f(-5.0f - hf));
    bf16x8 qf[4], kf[4], qb[4], kb[4];
    ChunkRaw raw[4];
#pragma unroll
    for (int it = 0; it < 4; ++it) chunk_load<GLA>(ci, t0 + 16 * it + row, h, kq, raw[it]);
    bf16x8 wfr[2]; f32x4 bfr[2]; if (GLA) chunk_gate_frags(wgl, h, row, kq, wfr, bfr);
#pragma unroll
    for (int it = 0; it < 4; ++it) {
        float bq[8], qv[8], kv[8];
        chunk_tile<GLA>(raw[it], wfr, bfr, h, it, row, kq, lg, carry, bq, qv, kv);
        float a[8], bneg[8], cpos[8], dneg[8];
#pragma unroll
        for (int j = 0; j < 8; ++j) { const float eb = __expf(bq[j]), enb = __expf(-bq[j]); a[j] = qv[j] * eb; bneg[j] = kv[j] * enb; cpos[j] = qv[j] * enb; dneg[j] = kv[j] * eb; }
        qf[it] = __builtin_bit_cast(bf16x8, (u32x4){cvtpk(a[0], a[1]), cvtpk(a[2], a[3]), cvtpk(a[4], a[5]), cvtpk(a[6], a[7])});
        kf[it] = __builtin_bit_cast(bf16x8, (u32x4){cvtpk(bneg[0], bneg[1]), cvtpk(bneg[2], bneg[3]), cvtpk(bneg[4], bneg[5]), cvtpk(bneg[6], bneg[7])});
        qb[it] = __builtin_bit_cast(bf16x8, (u32x4){cvtpk(cpos[0], cpos[1]), cvtpk(cpos[2], cpos[3]), cvtpk(cpos[4], cpos[5]), cvtpk(cpos[6], cpos[7])});
        kb[it] = __builtin_bit_cast(bf16x8, (u32x4){cvtpk(dneg[0], dneg[1]), cvtpk(dneg[2], dneg[3]), cvtpk(dneg[4], dneg[5]), cvtpk(dneg[6], dneg[7])});
        asm volatile("" ::: "memory");
    }
    __builtin_amdgcn_s_waitcnt(0); asm volatile("" ::: "memory");
    bf16x8 vfr[4][2], sfr[4];
#pragma unroll
    for (int et = 0; et < 4; ++et) {
#pragma unroll
        for (int p = 0; p < 2; ++p) {
            const u32x2 lo = *(const u32x2*)(wl + (16 * et + row) * GP + (32 * p + 4 * kq) * 2), hh = *(const u32x2*)(wl + (16 * et + row) * GP + (32 * p + 16 + 4 * kq) * 2);
            vfr[et][p] = __builtin_bit_cast(bf16x8, (u32x4){lo.x, lo.y, hh.x, hh.y});
        }
        sfr[et] = *(const bf16x8*)(sst + (16 * et + row) * 64 + kq * 16);
    }
    const int gcol = (GLA ? C_GR : C_RG) + h * 64, ocol = (GLA ? 512 : 768) + h * 64;
    float gn[4];
#pragma unroll
    for (int et = 0; et < 4; ++et) gn[et] = ng[16 * et + row];
#pragma unroll
    for (int it = 0; it < 4; ++it) {
        f32x4 st[4];
#pragma unroll
        for (int jt = 0; jt < 4; ++jt) {
            const f32x4 z = {0.f, 0.f, 0.f, 0.f};
            if (jt < it) st[jt] = __builtin_amdgcn_mfma_f32_16x16x32_bf16(kf[jt], qf[it], z, 0, 0, 0);
            else if (jt > it) st[jt] = __builtin_amdgcn_mfma_f32_16x16x32_bf16(kb[jt], qb[it], z, 0, 0, 0);
            else {
                const f32x4 lo = __builtin_amdgcn_mfma_f32_16x16x32_bf16(kf[jt], qf[it], z, 0, 0, 0), up = __builtin_amdgcn_mfma_f32_16x16x32_bf16(kb[jt], qb[it], z, 0, 0, 0);
#pragma unroll
                for (int r = 0; r < 4; ++r) st[jt][r] = (4 * kq + r <= row) ? lo[r] : up[r];
            }
        }
        bf16x8 af[2];
#pragma unroll
        for (int p = 0; p < 2; ++p)
            af[p] = __builtin_bit_cast(bf16x8, (u32x4){cvtpk(st[2 * p][0], st[2 * p][1]), cvtpk(st[2 * p][2], st[2 * p][3]), cvtpk(st[2 * p + 1][0], st[2 * p + 1][1]), cvtpk(st[2 * p + 1][2], st[2 * p + 1][3])});
        f32x4 o[4]; float ss[4] = {0.f, 0.f, 0.f, 0.f};
#pragma unroll
        for (int et = 0; et < 4; ++et) {
            f32x4 acc = {0.f, 0.f, 0.f, 0.f};
            acc = __builtin_amdgcn_mfma_f32_16x16x32_bf16(af[0], vfr[et][0], acc, 0, 0, 0);
            acc = __builtin_amdgcn_mfma_f32_16x16x32_bf16(af[1], vfr[et][1], acc, 0, 0, 0);
            acc = __builtin_amdgcn_mfma_f32_16x16x32_bf16(qf[it], sfr[et], acc, 0, 0, 0);
            o[et] = acc;
#pragma unroll
            for (int r = 0; r < 4; ++r) ss[r] += acc[r] * acc[r];
        }
#pragma unroll
        for (int r = 0; r < 4; ++r) {
            ss[r] += swz_xor<1>(ss[r]); ss[r] += swz_xor<2>(ss[r]); ss[r] += swz_xor<4>(ss[r]); ss[r] += swz_xor<8>(ss[r]);
            const float rs = rsqrtf(ss[r] * (1.0f / 64.0f) + EPS);
            const int t = t0 + 16 * it + 4 * kq + r;
#pragma unroll
            for (int et = 0; et < 4; ++et) {
                const int e = 16 * et + row;
                const float gt = __uint_as_float((unsigned)ci.proj[(size_t)t * DINP + gcol + e] << 16);
                const float val = o[et][r] * rs * gn[et] * pg8::silu_f(gt);
                omix[(size_t)t * 1024 + ocol + e] = (bf16_t)(cvtpk(val, 0.f) & 0xffffu);
            }
        }
    }
    __builtin_amdgcn_s_waitcnt(0); asm volatile("" ::: "memory");
}

#define XB_TMO      128
#define XB_XCNT(j)  (256  + 64 * (j))
#define XB_XSUB(j)  (1280 + 64 * (j))
#define XB_XGEN(j)  (2304 + 64 * (j))
#define XB_TOP      3328
#define XB_TOPGEN   3392
#define XCD_BAR_WORDS 3456
#define XB_SPIN_CAP (1u << 18)

__device__ __forceinline__ unsigned xb_ld(unsigned* p)              { return __hip_atomic_load(p, __ATOMIC_RELAXED, __HIP_MEMORY_SCOPE_AGENT); }
__device__ __forceinline__ unsigned xb_add(unsigned* p, unsigned v) { return __hip_atomic_fetch_add(p, v, __ATOMIC_RELAXED, __HIP_MEMORY_SCOPE_AGENT); }
__device__ __forceinline__ unsigned xb_xcc_id() { return (unsigned)__builtin_amdgcn_s_getreg((3 << 11) | 20) & 0xFu; }
#define XB_SPIN(cond, bar) do { unsigned _sp = 0; while (cond) { __builtin_amdgcn_s_sleep(1); \
    if ((++_sp & 255u) == 0u) { if (xb_ld(&(bar)[XB_TMO])) break; if (_sp > XB_SPIN_CAP) { atomicAdd(&(bar)[XB_TMO], 1u); break; } } } } while (0)

struct XcdBarrier {
    unsigned* bar; unsigned x;
    volatile LAS unsigned* st;
};

__device__ __forceinline__ XcdBarrier xcd_barrier_post(unsigned* bar, volatile LAS unsigned* st) {
    XcdBarrier b; b.bar = bar; b.x = xb_xcc_id(); b.st = st;
    if (threadIdx.x == 0) (void)xb_add(&bar[XB_XCNT(b.x)], 1u);
    return b;
}
__device__ __forceinline__ void xcd_barrier_complete(unsigned* bar, unsigned x, unsigned& nloc, unsigned& nx) {
    const unsigned G = gridDim.x * gridDim.y * gridDim.z;
    unsigned sum, cnt, mine, sp = 0u;
    for (;;) {
        sum = 0u; cnt = 0u; mine = 0u;
#pragma unroll
        for (unsigned j = 0; j < 16; ++j) { const unsigned c = xb_ld(&bar[XB_XCNT(j)]); sum += c; cnt += (c > 0u) ? 1u : 0u; mine = (j == x) ? c : mine; }
        if (sum == G) break;
        __builtin_amdgcn_s_sleep(1);
        if ((++sp & 255u) == 0u) { if (xb_ld(&bar[XB_TMO])) break; if (sp > XB_SPIN_CAP) { atomicAdd(&bar[XB_TMO], 1u); break; } }
    }
    nloc = mine > 0u ? mine : 1u; nx = cnt > 0u ? cnt : 1u;
}

__device__ __forceinline__ void xcd_barrier(const XcdBarrier& b) {
    asm volatile("s_waitcnt vmcnt(0)" ::: "memory");
    __syncthreads();
    if (threadIdx.x == 0) {
        unsigned* bar = b.bar;
        __builtin_amdgcn_s_waitcnt(0);
        unsigned nloc = b.st[0], nx = b.st[1];
        if (nloc == 0u) { xcd_barrier_complete(bar, b.x, nloc, nx); b.st[0] = nloc; b.st[1] = nx; }
        const unsigned old = xb_add(&bar[XB_XSUB(b.x)], 1u);
        const unsigned gen = old / nloc;
        if (old + 1u == (gen + 1u) * nloc) {
            __builtin_amdgcn_fence(__ATOMIC_RELEASE, "agent");
            asm volatile("s_waitcnt vmcnt(0)" ::: "memory");
            const unsigned og = xb_add(&bar[XB_TOP], 1u);
            const unsigned tg = og / nx;
            if (og + 1u == (tg + 1u) * nx) xb_add(&bar[XB_TOPGEN], 1u);
            else XB_SPIN(xb_ld(&bar[XB_TOPGEN]) == tg, bar);
            __builtin_amdgcn_fence(__ATOMIC_ACQUIRE, "agent");
            xb_add(&bar[XB_XGEN(b.x)], 1u);
            asm volatile("s_waitcnt vmcnt(0)" ::: "memory");
        } else {
            XB_SPIN(xb_ld(&bar[XB_XGEN(b.x)]) == gen, bar);
            __builtin_amdgcn_fence(__ATOMIC_ACQUIRE, "agent");
            asm volatile("s_waitcnt vmcnt(0)" ::: "memory");
        }
    }
    __syncthreads();
}


__global__ void __launch_bounds__(NWAVES * 64, 2) mega_fwd(Args args) {
    extern __shared__ __attribute__((aligned(16))) unsigned char lds[];
    const int lo = args.ph_lo, hi = args.ph_hi;
    const int wave_s = __builtin_amdgcn_readfirstlane((int)threadIdx.x >> 6);
    volatile LAS unsigned* bst = (volatile LAS unsigned*)((LAS unsigned char*)lds + BAR_LDS_OFF);
    if (threadIdx.x < 4) bst[threadIdx.x] = 0u;
    __syncthreads();
    XcdBarrier xbar = xcd_barrier_post((unsigned*)(args.ws + WS_CTL) + 64, bst);
#define WPTR(l, off) ((bf16_t*)(ws + WS_W + (size_t)(l) * WL_STRIDE + (off)))
#define INF(i, l, n) ((const float*)ap->in[i] + (size_t)(l) * (n))

    for (int ph = lo; ph < hi; ++ph) {
        { const int sp_ = (ph > 0) ? (ph - 1) % 12 : -1; if (sp_ == 2 || sp_ == 8 || sp_ == 11) continue; }
        if (ph > lo) { if (hi > (1 << 20)) cg::this_grid().sync(); else xcd_barrier(xbar); }
        const __attribute__((address_space(4))) Args* ap = (const __attribute__((address_space(4))) Args*)__builtin_amdgcn_kernarg_segment_ptr(); asm volatile("" : "+s"(ap));
        Ctx c; c.lds = lds; c.tid = 0; c.lane = 0; c.wave = wave_s; { int g_ = gridDim.x, b_ = blockIdx.x; asm volatile("" : "+s"(g_), "+s"(b_)); c.G = g_; c.bid = b_; }
#define FRESH_CTX() do { c.tid = fresh_tid(wave_s); c.lane = c.tid & 63; } while (0)
        unsigned char* ws = ap->ws;
        bf16_t* xb = (bf16_t*)(ws + WS_XB); float* rrow = (float*)(ws + WS_RR);
        float* xch = (float*)(ws + WS_F + 48 * MiB);
        bf16_t* Hb = (bf16_t*)(ws + WS_H); bf16_t* Fb = (bf16_t*)(ws + WS_F); bf16_t* Rb = (bf16_t*)(ws + WS_R); bf16_t* Qb = (bf16_t*)(ws + WS_Q);
        bf16_t* Kbuf = Hb; bf16_t* Vbuf = Fb; bf16_t* proj = Rb; bf16_t* omix = (bf16_t*)ap->out;
        float* dS = (float*)(ws + WS_DS); float* dec = (float*)(ws + WS_DEC); float* cs = (float*)(ws + WS_CS); float* sn = (float*)(ws + WS_SN);
        float* ssq = (float*)(ws + WS_SSQ); float* sskv = (float*)(ws + WS_SSKV);
        const int gw = c.bid * NWAVES + c.wave, NGW = c.G * NWAVES;
        PG8_LAS unsigned char* ldsl = (PG8_LAS unsigned char*)lds;
        if (ph == 0) {
            FRESH_CTX();
            float* scr = (float*)(lds + c.wave * 16384);
            constexpr int I_G = 16 * 88, I_D = 44 * 32, I_IN = 16 * 64, I_Q = 4 * 24, I_KV = 2 * 32, I_O = 16 * 32;
            constexpr int PER_L = 6 * I_G + I_IN + I_Q + I_KV + I_O;
            static_assert(I_G == I_D, "items");
            for (int it = gw; it < 2 * PER_L; it += NGW) {
                const int l = it / PER_L; int r = it % PER_L;
                if (r < I_G) { transpose_item(INF(4, l, D * FF), D, FF, WPTR(l, WL_GU1), 1, INF(2, l, D), scr, r, 88, c.lane); continue; } r -= I_G;
                if (r < I_G) { transpose_item(INF(5, l, D * FF), D, FF, WPTR(l, WL_GU1), 2, INF(2, l, D), scr, r, 88, c.lane); continue; } r -= I_G;
                if (r < I_D) { transpose_item(INF(6, l, D * FF), FF, D, WPTR(l, WL_D1), 0, nullptr, scr, r, 32, c.lane); continue; } r -= I_D;
                if (r < I_G) { transpose_item(INF(21, l, D * FF), D, FF, WPTR(l, WL_GU2), 1, INF(19, l, D), scr, r, 88, c.lane); continue; } r -= I_G;
                if (r < I_G) { transpose_item(INF(22, l, D * FF), D, FF, WPTR(l, WL_GU2), 2, INF(19, l, D), scr, r, 88, c.lane); continue; } r -= I_G;
                if (r < I_D) { transpose_item(INF(23, l, D * FF), FF, D, WPTR(l, WL_D2), 0, nullptr, scr, r, 32, c.lane); continue; } r -= I_D;
                if (r < I_IN) { transpose_item(INF(9, l, D * DIN), D, DIN, WPTR(l, WL_IN), 0, INF(7, l, D), scr, r, 64, c.lane); continue; } r -= I_IN;
                if (r < I_Q) { transpose_item(INF(11, l, 256 * 768), 256, 768, WPTR(l, WL_Q), 0, INF(10, l, 256), scr, r, 24, c.lane); continue; } r -= I_Q;
                if (r < I_KV) { transpose_item(INF(13, l, 128 * 1024), 128, 1024, WPTR(l, WL_KV), 0, INF(12, l, 128), scr, r, 32, c.lane); continue; } r -= I_KV;
                transpose_item(INF(18, l, D * D), D, D, WPTR(l, WL_OUT), 0, nullptr, scr, r, 32, c.lane);
            }
            { const int* pos = (const int*)ap->in[1];
              for (int i = c.bid * 512 + c.tid; i < T * 16; i += c.G * 512) {
                  const int t = i >> 4, j = i & 15;
                  const float inv = exp2f(-(float)(2 * j) * (1.0f / 32.0f) * 13.287712379549449f);
                  const float ang = (float)pos[t] * inv;
                  const double rv = (double)ang * 0.15915494309189535; const float rr = (float)(rv - rint(rv));
                  cs[i] = __builtin_amdgcn_cosf(rr); sn[i] = __builtin_amdgcn_sinf(rr);
              } }
            resnorm_phase(c, nullptr, (const float*)ap->in[0], xb, nullptr, nullptr, 0.f, rrow);
            continue;
        }
        const int l = (ph - 1) / 12, sp = (ph - 1) % 12;
        if (sp == 0 || sp == 9) {
            pg8::Gemm g{xb, WPTR(l, sp == 0 ? WL_GU1 : WL_GU2), T, 2 * FF, D, D}; pg8::StaticOrder S; S.init(T, 2 * FF, c.G, c.bid);
            pg8::EpiSwiglu E{Rb, FF, rrow};
            for (int rep = 0; rep <= PROBE_GU; ++rep)
            pg8::gemm_phase<pg8::EpiSwiglu>(ldsl, g, S, E, wave_s);
        } else if (sp == 1 || sp == 10) {
            pg8::Gemm g{Rb, WPTR(l, sp == 1 ? WL_D1 : WL_D2), T, D, FF, FF}; pg8::StaticOrder S; S.init(T, D, c.G, c.bid);
            const bool fin = (l == 1 && sp == 10);
            pg8::EpiRes E{xb, fin ? ap->out : nullptr, sp == 1 ? INF(3, l, D) : INF(20, l, D), 0.5f, xch, (unsigned*)(ws + 65536) + (size_t)(l * 3 + (sp == 1 ? 0 : 2)) * 128 * 64, rrow};
            pg8::gemm_phase<pg8::EpiRes>(ldsl, g, S, E, wave_s);
        } else if (sp == 2) {
            FRESH_CTX();
            resnorm_phase(c, Fb, nullptr, xb, nullptr, INF(3, l, D), 0.5f, rrow);
        } else if (sp == 3) {
            pg8::Gemm g{xb, WPTR(l, WL_IN), T, DINP, D, D}; pg8::StaticOrder S; S.init(T, DINP, c.G, c.bid);
            pg8::EpiPlain E{proj, DINP, ssq, sskv, rrow};
            pg8::gemm_phase<pg8::EpiPlain>(ldsl, g, S, E, wave_s);
        } else if (sp == 4) {
            { pg8::Gemm g{proj + C_MQ, WPTR(l, WL_Q), T, 768, 256, DINP}; pg8::StaticOrder S; S.init(T, 768, c.G, c.bid);
              pg8::EpiQ E{Qb, ssq, cs, sn};
              for (int rep = 0; rep <= PROBE_SMALL; ++rep) pg8::gemm_phase<pg8::EpiQ>(ldsl, g, S, E, wave_s); }
            __syncthreads();
            { pg8::Gemm g{proj + C_MKV, WPTR(l, WL_KV), T, 1024, 128, DINP}; pg8::StaticOrder S; S.init(T, 1024, c.G, c.bid);
              pg8::EpiKV E{Kbuf, Vbuf, sskv, proj, cs, sn};
              for (int rep = 0; rep <= PROBE_SMALL; ++rep) { __syncthreads(); pg8::gemm_phase<pg8::EpiKV>(ldsl, g, S, E, wave_s); } }
            __syncthreads();
            float* wgl = (float*)(lds + WG_LDS_OFF);
            { const int t_ = fresh_tid(wave_s); const float* wsrc = INF(14, l, 16 * 128); const float* bsrc = INF(15, l, 128);
              for (int i = t_; i < 2048 + 128; i += NWAVES * 64) wgl[i] = (i < 2048) ? wsrc[i] : bsrc[i - 2048]; }
            __syncthreads();
            ChunkIn ci{proj, INF(14, l, 16 * 128), INF(15, l, 128), cs, sn};
            unsigned char* wl = lds + c.wave * 16384;
            for (int rep = 0; rep <= PROBE_CHUNK; ++rep)
            for (int u = gw; u < 4096; u += NGW) {
                const int lane2 = fresh_tid(wave_s) & 63;
                if (u < 2048) chunk_pass_a<true>(ci, wgl, u, wl, lane2, dS, dec);
                else chunk_pass_a<false>(ci, wgl, u - 2048, wl, lane2, dS + (size_t)2048 * 2048, dec + 2048 * 32);
            }
        } else if (sp == 5) {
            FRESH_CTX();
            for (int gi = c.bid * 512 + c.tid; gi < 131072; gi += c.G * 512) {
                const int e = gi & 63, d = (gi >> 6) & 31, h = (gi >> 11) & 3, b = (gi >> 13) & 7, ty = gi >> 16;
                float* base = dS + (size_t)ty * 2048 * 2048; const float* db = dec + (size_t)ty * 2048 * 32;
                float s = 0.f;
                for (int n0 = 0; n0 < 64; n0 += 16) {
                    float ds[16], dc[16];
#pragma unroll
                    for (int j = 0; j < 16; ++j) { const int unit = (b * 64 + n0 + j) * 4 + h; ds[j] = base[(size_t)unit * 2048 + d * 64 + e]; dc[j] = db[unit * 32 + d]; }
#pragma unroll
                    for (int j = 0; j < 16; ++j) { const int unit = (b * 64 + n0 + j) * 4 + h; base[(size_t)unit * 2048 + d * 64 + e] = s; s = dc[j] * s + ds[j]; }
                }
            }
            const int vcu = (c.G % 8 == 0) ? (c.bid % 8) * (c.G / 8) + c.bid / 8 : c.bid;
            for (int rep = 0; rep <= PROBE_ATTN; ++rep)
            for (int i = vcu; i < 1024; i += c.G) {
                const int j = i >> 8, ii = i & 255, bh = ii >> 2, s4 = ii & 3;
                const int qb = (j == 0) ? s4 : (j == 1) ? 7 - s4 : (j == 2) ? 8 + s4 : 15 - s4;
                attn_unit(c, bh, qb, Qb, Kbuf, Vbuf, omix);
            }
        } else if (sp == 6) {
            FRESH_CTX();
            float* wgl = (float*)(lds + WG_LDS_OFF);
            { const int t_ = fresh_tid(wave_s); const float* wsrc = INF(14, l, 16 * 128); const float* bsrc = INF(15, l, 128);
              for (int i = t_; i < 2048 + 128; i += NWAVES * 64) wgl[i] = (i < 2048) ? wsrc[i] : bsrc[i - 2048]; }
            __syncthreads();
            ChunkIn ci{proj, INF(14, l, 16 * 128), INF(15, l, 128), cs, sn};
            unsigned char* wl = lds + c.wave * 16384;
            for (int rep = 0; rep <= PROBE_CHUNK; ++rep)
            for (int u = gw; u < 4096; u += NGW) {
                const int lane2 = fresh_tid(wave_s) & 63;
                if (u < 2048) chunk_pass_c<true>(ci, wgl, u, wl, lane2, dS, INF(16, l, 64), omix);
                else chunk_pass_c<false>(ci, wgl, u - 2048, wl, lane2, dS + (size_t)2048 * 2048, INF(17, l, 64), omix);
            }
        } else if (sp == 7) {
            pg8::Gemm g{omix, WPTR(l, WL_OUT), T, D, D, D}; pg8::StaticOrder S; S.init(T, D, c.G, c.bid);
            pg8::EpiRes E{xb, nullptr, INF(8, l, D), 1.0f, xch, (unsigned*)(ws + 65536) + (size_t)(l * 3 + 1) * 128 * 64, rrow};
            pg8::gemm_phase<pg8::EpiRes>(ldsl, g, S, E, wave_s);
        } else if (sp == 8) {
            FRESH_CTX();
            resnorm_phase(c, Fb, nullptr, xb, nullptr, INF(8, l, D), 1.0f, rrow);
        } else {
            FRESH_CTX();
            resnorm_phase(c, Fb, nullptr, xb, (l == 1) ? ap->out : nullptr, INF(20, l, D), 0.5f, (l == 0) ? rrow : nullptr);
        }
    }
}

constexpr int N_PHASES = 25;

extern "C" void kernel_launch(void* const* d_in, const int* in_sizes, int n_in, void* d_out, int out_size, void* d_ws, size_t ws_size, hipStream_t stream) {
    static int grid = 0;
    if (grid == 0) {
        if (n_in != 24 || in_sizes[0] != T * D || out_size != T * D || ws_size < WS_END) { fprintf(stderr, "kernel_launch: unexpected shapes (n_in %d, in0 %d, out %d, ws %zu < %zu)\n", n_in, n_in > 0 ? in_sizes[0] : -1, out_size, ws_size, (size_t)WS_END); grid = -1; return; }
        int dev = 0, cus = 0, per_cu = 0;
        hipGetDevice(&dev); hipDeviceGetAttribute(&cus, hipDeviceAttributeMultiprocessorCount, dev);
        if (hipFuncSetAttribute((const void*)mega_fwd, hipFuncAttributeMaxDynamicSharedMemorySize, LDS_BYTES) != hipSuccess) { fprintf(stderr, "kernel_launch: hipFuncSetAttribute failed\n"); grid = -1; return; }
        if (hipOccupancyMaxActiveBlocksPerMultiprocessor(&per_cu, (const void*)mega_fwd, NWAVES * 64, LDS_BYTES) != hipSuccess || per_cu < 1) { fprintf(stderr, "kernel_launch: occupancy query says %d\n", per_cu); per_cu = 1; }
        (void)hipGetLastError();
        grid = cus * per_cu;
    }
    if (grid < 0) return;
    if (hipMemsetAsync((char*)d_ws + WS_CTL, 0, 1 << 20, stream) != hipSuccess) { fprintf(stderr, "kernel_launch: memset of the barrier words failed\n"); return; }
    Args a{};
    for (int i = 0; i < 24; ++i) a.in[i] = d_in[i];
    a.out = (float*)d_out; a.ws = (unsigned char*)d_ws;
#if MK_ONE_LAUNCH
    a.ph_lo = 0; a.ph_hi = N_PHASES;
    void* kargs[] = {&a};
    hipError_t e = hipLaunchCooperativeKernel((const void*)mega_fwd, dim3(grid), dim3(NWAVES * 64), kargs, LDS_BYTES, stream);
    if (e != hipSuccess) fprintf(stderr, "cooperative launch failed: %s (grid %d)\n", hipGetErrorString(e), grid);
#else
    for (int p = 0; p < N_PHASES; ++p) {
        a.ph_lo = p; a.ph_hi = p + 1;
        hipLaunchKernelGGL(mega_fwd, dim3(grid), dim3(NWAVES * 64), LDS_BYTES, stream, a);
    }
#endif
}
```

```cpp
#include <hip/hip_runtime.h>
#include <hip/hip_cooperative_groups.h>
#include <cstdio>
#include <cstdint>
namespace cg = cooperative_groups;

#ifndef PROBE_ATTN
#define PROBE_ATTN 0
#endif
#ifndef PROBE_GU
#define PROBE_GU 0
#endif
#ifndef PROBE_DOWN
#define PROBE_DOWN 0
#endif
#ifndef PROBE_CHUNK
#define PROBE_CHUNK 0
#endif
#ifndef PROBE_SMALL
#define PROBE_SMALL 0
#endif
#ifndef MK_ONE_LAUNCH
#define MK_ONE_LAUNCH 1
#endif

typedef unsigned short bf16_t;
typedef short bf16x8 __attribute__((ext_vector_type(8)));
typedef float f32x4 __attribute__((ext_vector_type(4)));
typedef float f32x16 __attribute__((ext_vector_type(16)));
typedef unsigned u32x4 __attribute__((ext_vector_type(4)));
typedef unsigned u32x2 __attribute__((ext_vector_type(2)));
typedef short v4i16_t __attribute__((ext_vector_type(4)));
#define LAS __attribute__((address_space(3)))
typedef float f32x2_t __attribute__((ext_vector_type(2)));
typedef __bf16 bf16x2_t __attribute__((ext_vector_type(2)));

__device__ __forceinline__ unsigned cvtpk(float lo, float hi) { f32x2_t v = {lo, hi}; bf16x2_t b = __builtin_convertvector(v, bf16x2_t); return __builtin_bit_cast(unsigned, b); }
__device__ __forceinline__ float bflo(unsigned w) { return __uint_as_float(w << 16); }
__device__ __forceinline__ float bfhi(unsigned w) { return __uint_as_float(w & 0xffff0000u); }
template <int X> __device__ __forceinline__ float swz_xor(float v) { return __int_as_float(__builtin_amdgcn_ds_swizzle(__float_as_int(v), (X << 10) | 0x1F)); }
__device__ __forceinline__ float wave_sum(float v) {
    v += swz_xor<1>(v); v += swz_xor<2>(v); v += swz_xor<4>(v); v += swz_xor<8>(v); v += swz_xor<16>(v);
    auto r = __builtin_amdgcn_permlane32_swap(__float_as_uint(v), __float_as_uint(v), false, false); return __uint_as_float(r[0]) + __uint_as_float(r[1]);
}

__device__ __forceinline__ float add_xor16(float v) { return v + __int_as_float(__builtin_amdgcn_ds_swizzle(__float_as_int(v), 0x401F)); }
__device__ __forceinline__ float add_xor32(float v) { auto r = __builtin_amdgcn_permlane32_swap(__float_as_uint(v), __float_as_uint(v), false, false); return __uint_as_float(r[0]) + __uint_as_float(r[1]); }

__device__ __forceinline__ int fresh_tid(int wave_s) { unsigned z = 0; asm volatile("" : "+v"(z)); return wave_s * 64 + (int)__builtin_amdgcn_mbcnt_hi(~0u, __builtin_amdgcn_mbcnt_lo(~0u, z)); }

constexpr int T = 32768, SEQ = 4096, D = 1024, FF = 2816, DINP = 2048, DIN = 1968;
constexpr int C_MQ = 0, C_MKV = 256, C_MKR = 384, C_GQ = 416, C_GK = 544, C_GV = 672, C_GG = 928, C_GR = 944, C_RQ = 1200, C_RK = 1328, C_RV = 1456, C_RG = 1712;
constexpr float EPS = 1e-6f;
constexpr float QSCALE = 0.10206207261596577f * 1.4426950408889634f;

namespace pg8 {
#define PG8_LAS __attribute__((address_space(3)))
constexpr int BM = 256, BK = 64, HALF = 128, HTB = HALF * BK * 2, STAGE_BYTES = 8 * HTB, NXCD = 8, WGM = 8;

__host__ __device__ __forceinline__ int lds_byte(int r, int c) { const int st = (r >> 4) * 2 + (c >> 5), rr = r & 15, cc = c & 31, ob = rr * 64 + cc * 2; return st * 1024 + (ob ^ (((ob >> 9) & 1) << 5)); }
__host__ __device__ __forceinline__ void stage_rc(int b, int& R, int& C) { const int st = b / 1024, sb = b % 1024, swz = sb ^ (((sb >> 9) & 1) << 5); R = (st >> 1) * 16 + swz / 64; C = (st & 1) * 32 + (swz % 64) / 2; }
__host__ __device__ __forceinline__ int perm32(int rho) { const int n = rho >> 4, i = rho & 15; return 8 * (i >> 2) + 4 * n + (i & 3); }

struct Unit { int pm, pn; };
struct Gemm { const bf16_t* A; const bf16_t* Bt; int M, N, K, lda; };

struct StaticOrder {
    int nM, nN, nwg, G, c;
    __host__ __device__ void init(int M, int N, int G_, int c_) { nM = M / BM; nN = N / BM; nwg = nM * nN; G = G_; c = c_; }
    __host__ __device__ bool next(int i, Unit& u) const {
        const long L = (long)i * G + c; if (L >= nwg) return false;
        int wgid = (int)L; { const int q = nwg / NXCD, r = nwg % NXCD, xcd = wgid % NXCD, off = wgid / NXCD; wgid = (xcd < r ? xcd * (q + 1) : r * (q + 1) + (xcd - r) * q) + off; }
        const int nig = WGM * nN, gid = wgid / nig, fm = gid * WGM, gsz = (nM - fm) < WGM ? (nM - fm) : WGM;
        u.pm = fm + ((wgid % nig) % gsz); u.pn = (wgid % nig) / gsz; return true;
    }
};


__device__ __forceinline__ float silu_f(float g) { return g * __builtin_amdgcn_rcpf(1.0f + __expf(-g)); }

struct EpiSwiglu {
    bf16_t* O; int ldc; const float* rr;
    __device__ __forceinline__ void prefetch(const Unit& u, int wr, int fr, float (&pre)[8]) const {
#pragma unroll
        for (int i = 0; i < 8; ++i) pre[i] = rr[u.pm * BM + wr * 64 + fr + (i >> 2) * HALF + (i & 3) * 16];
    }
    __device__ __forceinline__ void operator()(const f32x4 (&acc)[2][2][4][2], const Unit& u, int wr, int wc, int fr, int fq, const float (&pre)[8]) const {
        const int row0 = u.pm * BM + wr * 64 + fr; const int col0 = u.pn * 128 + wc * 32 + 8 * fq;
#pragma unroll
        for (int ai = 0; ai < 2; ++ai)
#pragma unroll
            for (int m = 0; m < 4; ++m) {
                bf16_t* rowp = O + (size_t)(row0 + ai * HALF + m * 16) * ldc + col0;
                const float rs = pre[ai * 4 + m];
                const f32x4 g0 = acc[ai][0][m][0] * rs, g1 = acc[ai][0][m][1] * rs, u0 = acc[ai][1][m][0] * rs, u1 = acc[ai][1][m][1] * rs;
                u32x4 w;
                w.x = cvtpk(silu_f(g0[0]) * u0[0], silu_f(g0[1]) * u0[1]); w.y = cvtpk(silu_f(g0[2]) * u0[2], silu_f(g0[3]) * u0[3]);
                w.z = cvtpk(silu_f(g1[0]) * u1[0], silu_f(g1[1]) * u1[1]); w.w = cvtpk(silu_f(g1[2]) * u1[2], silu_f(g1[3]) * u1[3]);
                *(u32x4*)rowp = w;
            }
    }
};

struct EpiPlain {
    bf16_t* O; int ldc; float* ssq; float* sskv; const float* rr;
    __device__ __forceinline__ void prefetch(const Unit& u, int wr, int fr, float (&pre)[8]) const {
#pragma unroll
        for (int i = 0; i < 8; ++i) pre[i] = rr ? rr[u.pm * BM + wr * 64 + fr + (i >> 2) * HALF + (i & 3) * 16] : 1.0f;
    }
    __device__ __forceinline__ void operator()(const f32x4 (&acc)[2][2][4][2], const Unit& u, int wr, int wc, int fr, int fq, const float (&pre)[8]) const {
        const int row0 = u.pm * BM + wr * 64 + fr; const int col0 = u.pn * BM + wc * 32 + 8 * fq;
        const bool do_q = (ssq != nullptr) && (u.pn == 0), do_kv = (ssq != nullptr) && (u.pn == 1);
#pragma unroll
        for (int ai = 0; ai < 2; ++ai)
#pragma unroll
            for (int m = 0; m < 4; ++m) {
                const int row = row0 + ai * HALF + m * 16;
                bf16_t* rowp = O + (size_t)row * ldc + col0;
                const float rs = pre[ai * 4 + m];
#pragma unroll
                for (int bj = 0; bj < 2; ++bj) {
                    const f32x4 v0 = acc[ai][bj][m][0] * rs, v1 = acc[ai][bj][m][1] * rs;
                    u32x4 w; w.x = cvtpk(v0[0], v0[1]); w.y = cvtpk(v0[2], v0[3]); w.z = cvtpk(v1[0], v1[1]); w.w = cvtpk(v1[2], v1[3]);
                    *(u32x4*)(rowp + bj * HALF) = w;
                    if (do_q || (do_kv && bj == 0)) {
                        float s = (v0[0] * v0[0] + v0[1] * v0[1]) + (v0[2] * v0[2] + v0[3] * v0[3]) + (v1[0] * v1[0] + v1[1] * v1[1]) + (v1[2] * v1[2] + v1[3] * v1[3]);
                        s = add_xor16(s); s = add_xor32(s);
                        if (fq == 0) { if (do_q) ssq[(size_t)row * 8 + bj * 4 + wc] = s; else sskv[(size_t)row * 4 + wc] = s; }
                    }
                }
            }
    }
};

struct EpiQ {
    bf16_t* Q; const float* ssq; const float* cs; const float* sn;
    __device__ __forceinline__ void prefetch(const Unit&, int, int, float (&pre)[8]) const {
#pragma unroll
        for (int i = 0; i < 8; ++i) pre[i] = 0.f; }
    __device__ __forceinline__ void operator()(const f32x4 (&acc)[2][2][4][2], const Unit& u, int wr, int wc, int fr, int fq, const float (&)[8]) const {
        const int row0 = u.pm * BM + wr * 64 + fr; const int col0 = u.pn * BM + wc * 32 + 8 * fq;
        const int dd = 8 * (fq & 1);
#pragma unroll
        for (int ai = 0; ai < 2; ++ai)
#pragma unroll
            for (int m = 0; m < 4; ++m) {
                const int row = row0 + ai * HALF + m * 16;
                const f32x4 s0 = *(const f32x4*)(ssq + (size_t)row * 8), s1 = *(const f32x4*)(ssq + (size_t)row * 8 + 4);
                const float tot = ((s0[0] + s0[1]) + (s0[2] + s0[3])) + ((s1[0] + s1[1]) + (s1[2] + s1[3]));
                const float sc = rsqrtf(tot * (1.0f / 256.0f) + EPS) * QSCALE;
                bf16_t* rowp = Q + (size_t)row * 768 + col0;
#pragma unroll
                for (int bj = 0; bj < 2; ++bj) {
                    f32x4 v0 = acc[ai][bj][m][0] * sc, v1 = acc[ai][bj][m][1] * sc;
                    const int G = 8 * u.pn + 4 * bj + wc;
                    if ((G % 3) == 2) {
                        const f32x4 c0 = *(const f32x4*)(cs + (size_t)row * 16 + dd), c1 = *(const f32x4*)(cs + (size_t)row * 16 + dd + 4);
                        const f32x4 n0 = *(const f32x4*)(sn + (size_t)row * 16 + dd), n1 = *(const f32x4*)(sn + (size_t)row * 16 + dd + 4);
                        f32x4 p0, p1;
#pragma unroll
                        for (int j = 0; j < 4; ++j) { auto s0_ = __builtin_amdgcn_permlane32_swap(__float_as_uint(v0[j]), __float_as_uint(v0[j]), false, false); auto s1_ = __builtin_amdgcn_permlane32_swap(__float_as_uint(v1[j]), __float_as_uint(v1[j]), false, false);
                            p0[j] = __uint_as_float(fq < 2 ? s0_[1] : s0_[0]); p1[j] = __uint_as_float(fq < 2 ? s1_[1] : s1_[0]); }
                        if (fq < 2) { v0 = v0 * c0 - p0 * n0; v1 = v1 * c1 - p1 * n1; }
                        else        { v0 = p0 * n0 + v0 * c0; v1 = p1 * n1 + v1 * c1; }
                    }
                    u32x4 w; w.x = cvtpk(v0[0], v0[1]); w.y = cvtpk(v0[2], v0[3]); w.z = cvtpk(v1[0], v1[1]); w.w = cvtpk(v1[2], v1[3]);
                    *(u32x4*)(rowp + bj * HALF) = w;
                }
                if (m & 1) asm volatile("" ::: "memory");
            }
    }
};

struct EpiKV {
    bf16_t* Kb; bf16_t* Vb; const float* sskv; const bf16_t* proj; const float* cs; const float* sn;
    __device__ __forceinline__ void prefetch(const Unit&, int, int, float (&pre)[8]) const {
#pragma unroll
        for (int i = 0; i < 8; ++i) pre[i] = 0.f; }
    __device__ __forceinline__ void operator()(const f32x4 (&acc)[2][2][4][2], const Unit& u, int wr, int wc, int fr, int fq, const float (&)[8]) const {
        const int row0 = u.pm * BM + wr * 64 + fr;
#pragma unroll
        for (int ai = 0; ai < 2; ++ai)
#pragma unroll
            for (int m = 0; m < 4; ++m) {
                const int row = row0 + ai * HALF + m * 16;
                const f32x4 s0 = *(const f32x4*)(sskv + (size_t)row * 4);
                const float sc = rsqrtf(((s0[0] + s0[1]) + (s0[2] + s0[3])) * (1.0f / 128.0f) + EPS);
#pragma unroll
                for (int bj = 0; bj < 2; ++bj) {
                    const f32x4 v0 = acc[ai][bj][m][0] * sc, v1 = acc[ai][bj][m][1] * sc;
                    u32x4 w; w.x = cvtpk(v0[0], v0[1]); w.y = cvtpk(v0[2], v0[3]); w.z = cvtpk(v1[0], v1[1]); w.w = cvtpk(v1[2], v1[3]);
                    const int head = 2 * u.pn + bj;
                    if (wc < 2) *(u32x4*)(Kb + (size_t)row * 768 + head * 96 + wc * 32 + 8 * fq) = w;
                    else        *(u32x4*)(Vb + (size_t)row * 512 + head * 64 + (wc - 2) * 32 + 8 * fq) = w;
                }
                if (wc < 2) {
                    const u32x2 a = *(const u32x2*)(proj + (size_t)row * DINP + C_MKR + 4 * fq), b = *(const u32x2*)(proj + (size_t)row * DINP + C_MKR + 16 + 4 * fq);
                    const f32x4 c = *(const f32x4*)(cs + (size_t)row * 16 + 4 * fq), s = *(const f32x4*)(sn + (size_t)row * 16 + 4 * fq);
                    const f32x4 x1 = {bflo(a.x), bfhi(a.x), bflo(a.y), bfhi(a.y)}, x2 = {bflo(b.x), bfhi(b.x), bflo(b.y), bfhi(b.y)};
                    const f32x4 o = (wc == 0) ? (x1 * c - x2 * s) : (x1 * s + x2 * c);
                    u32x2 w; w.x = cvtpk(o[0], o[1]); w.y = cvtpk(o[2], o[3]);
#pragma unroll
                    for (int bj = 0; bj < 2; ++bj) *(u32x2*)(Kb + (size_t)row * 768 + (2 * u.pn + bj) * 96 + 64 + wc * 16 + 4 * fq) = w;
                }
                if (m & 1) asm volatile("" ::: "memory");
            }
    }
};

struct EpiRes {
    bf16_t* xb; float* xf32; const float* post_g; float scale; float* xch; unsigned* cnt; float* rr;
    __device__ __forceinline__ void prefetch(const Unit&, int, int, float (&pre)[8]) const {
#pragma unroll
        for (int i = 0; i < 8; ++i) pre[i] = 0.f; }
    __device__ __forceinline__ void operator()(const f32x4 (&acc)[2][2][4][2], const Unit& u, int wr, int wc, int fr, int fq, const float (&)[8]) const {
        int zl_ = 0; asm volatile("" : "+v"(zl_));
        LAS float* P = (LAS float*)(132096 + zl_);
        LAS float* S = P + 1024;
        float* xnp = xch + 4 * 65536;
        const int wid = wr * 4 + wc, lane = fq * 16 + fr, tid = wid * 64 + lane;
#define ER_BAR() do { asm volatile("s_waitcnt lgkmcnt(0)" ::: "memory"); __builtin_amdgcn_s_barrier(); asm volatile("" ::: "memory"); } while (0)
        const int col0 = u.pn * BM + wc * 32 + 8 * fq;
        u32x4 xw[2][4][2]; f32x4 gg[2][2];
#pragma unroll
        for (int ai = 0; ai < 2; ++ai)
#pragma unroll
            for (int m = 0; m < 4; ++m)
#pragma unroll
                for (int bj = 0; bj < 2; ++bj) xw[ai][m][bj] = *(const u32x4*)(xb + (size_t)(u.pm * BM + ai * HALF + wr * 64 + m * 16 + fr) * 1024 + col0 + bj * HALF);
#pragma unroll
        for (int bj = 0; bj < 2; ++bj) { gg[bj][0] = *(const f32x4*)(post_g + col0 + bj * HALF); gg[bj][1] = *(const f32x4*)(post_g + col0 + bj * HALF + 4); }
#pragma unroll
        for (int ai = 0; ai < 2; ++ai)
#pragma unroll
            for (int m = 0; m < 4; ++m) {
                float sq = 0.f;
#pragma unroll
                for (int bj = 0; bj < 2; ++bj)
#pragma unroll
                    for (int n = 0; n < 2; ++n) { const f32x4 v = acc[ai][bj][m][n]; sq += (v[0] * v[0] + v[1] * v[1]) + (v[2] * v[2] + v[3] * v[3]); }
                sq = add_xor16(sq); sq = add_xor32(sq);
                if (fq == 0) P[(ai * HALF + wr * 64 + m * 16 + fr) * 4 + wc] = sq;
            }
        ER_BAR();
        if (tid < 256) { const float tot = (P[tid * 4] + P[tid * 4 + 1]) + (P[tid * 4 + 2] + P[tid * 4 + 3]);
            __hip_atomic_store((unsigned*)xch + ((size_t)(u.pm * BM + tid) * 4 + u.pn), __float_as_uint(tot), __ATOMIC_RELAXED, __HIP_MEMORY_SCOPE_AGENT); }
        asm volatile("s_waitcnt vmcnt(0)" ::: "memory");
        if (lane == 0) __hip_atomic_fetch_add(cnt + 64 * u.pm, 1u, __ATOMIC_RELAXED, __HIP_MEMORY_SCOPE_AGENT);
        if (wid == 0) {
            unsigned spins = 0;
            while ((unsigned)__builtin_amdgcn_readfirstlane(__hip_atomic_load(cnt + 64 * u.pm, __ATOMIC_RELAXED, __HIP_MEMORY_SCOPE_AGENT)) < 32u) { __builtin_amdgcn_s_sleep(2); if (++spins > (1u << 22)) break; }
            __builtin_amdgcn_fence(__ATOMIC_ACQUIRE, "agent");
        }
        asm volatile("s_waitcnt vmcnt(0)" ::: "memory");
        ER_BAR();
        if (tid < 256) { const unsigned* xs = (const unsigned*)xch + (size_t)(u.pm * BM + tid) * 4; float tot = 0.f;
#pragma unroll
            for (int t = 0; t < 4; ++t) tot += __uint_as_float(__hip_atomic_load(xs + t, __ATOMIC_RELAXED, __HIP_MEMORY_SCOPE_AGENT));
            S[tid] = rsqrtf(tot * (1.0f / 1024.0f) + EPS) * scale; }
        ER_BAR();
#pragma unroll
        for (int ai = 0; ai < 2; ++ai)
#pragma unroll
            for (int m = 0; m < 4; ++m) {
                const int rl = ai * HALF + wr * 64 + m * 16 + fr; const size_t row = (size_t)(u.pm * BM + rl);
                const float rf = S[rl]; float s2 = 0.f;
#pragma unroll
                for (int bj = 0; bj < 2; ++bj) {
                    const u32x4 xq = xw[ai][m][bj];
                    const f32x4 x0 = {bflo(xq.x), bfhi(xq.x), bflo(xq.y), bfhi(xq.y)}, x1 = {bflo(xq.z), bfhi(xq.z), bflo(xq.w), bfhi(xq.w)};
                    const f32x4 v0 = x0 + acc[ai][bj][m][0] * rf * gg[bj][0], v1 = x1 + acc[ai][bj][m][1] * rf * gg[bj][1];
                    s2 += ((v0[0] * v0[0] + v0[1] * v0[1]) + (v0[2] * v0[2] + v0[3] * v0[3])) + ((v1[0] * v1[0] + v1[1] * v1[1]) + (v1[2] * v1[2] + v1[3] * v1[3]));
                    if (xf32) { *(f32x4*)(xf32 + row * 1024 + col0 + bj * HALF) = v0; *(f32x4*)(xf32 + row * 1024 + col0 + bj * HALF + 4) = v1; }
                    else { u32x4 w; w.x = cvtpk(v0[0], v0[1]); w.y = cvtpk(v0[2], v0[3]); w.z = cvtpk(v1[0], v1[1]); w.w = cvtpk(v1[2], v1[3]); *(u32x4*)(xb + row * 1024 + col0 + bj * HALF) = w; }
                }
                s2 = add_xor16(s2); s2 = add_xor32(s2);
                if (fq == 0) P[rl * 4 + wc] = s2;
            }
        ER_BAR();
        if (!xf32) {
            if (tid < 256) __hip_atomic_store((unsigned*)xnp + ((size_t)(u.pm * BM + tid) * 4 + u.pn), __float_as_uint((P[tid * 4] + P[tid * 4 + 1]) + (P[tid * 4 + 2] + P[tid * 4 + 3])), __ATOMIC_RELAXED, __HIP_MEMORY_SCOPE_AGENT);
            asm volatile("s_waitcnt vmcnt(0)" ::: "memory");
            ER_BAR();
            if (tid == 0) { const unsigned old = __hip_atomic_fetch_add(cnt + 6 * 128 * 64 + 64 * u.pm, 1u, __ATOMIC_RELAXED, __HIP_MEMORY_SCOPE_AGENT); __builtin_amdgcn_fence(__ATOMIC_ACQUIRE, "agent"); S[0] = (old == 3u) ? 1.0f : 0.0f; }
            asm volatile("s_waitcnt vmcnt(0)" ::: "memory");
            ER_BAR();
            if (S[0] != 0.0f && tid < 256) { const unsigned* xs = (const unsigned*)xnp + (size_t)(u.pm * BM + tid) * 4; float tot = 0.f;
#pragma unroll
                for (int t = 0; t < 4; ++t) tot += __uint_as_float(__hip_atomic_load(xs + t, __ATOMIC_RELAXED, __HIP_MEMORY_SCOPE_AGENT));
                rr[u.pm * BM + tid] = rsqrtf(tot * (1.0f / 1024.0f) + EPS); }
        }
#undef ER_BAR
    }
};

template <class Epi>
__device__ __forceinline__ void gemm_phase(PG8_LAS unsigned char* lds, const Gemm g, const StaticOrder& S, const Epi& E, const int wave_s) {
    const int tid = fresh_tid(wave_s);
    const int wid = __builtin_amdgcn_readfirstlane(tid >> 6), lane = tid & 63, wr = wid >> 2, wc = wid & 3, fr = lane & 15, fq = lane >> 4;
    int K_ = g.K, lda_ = g.lda; asm volatile("" : "+s"(K_), "+s"(lda_));
    const int K = K_, nt = K / BK, lda = lda_;
    unsigned voffA[2], voffB[2];
#pragma unroll
    for (int i = 0; i < 2; ++i) { int R, C; stage_rc(tid * 16 + i * 8192, R, C); const int Rb = (R & ~31) + perm32(R & 31);
        voffA[i] = (unsigned)(R * lda + C) * 2u; voffB[i] = (unsigned)(Rb * K + C) * 2u; }
    const size_t kstep = (size_t)(BK * 2);
    const size_t hstepA = (size_t)HALF * lda * 2, hstepB = (size_t)HALF * K * 2;
    const size_t tstepA = 2 * hstepA, tstepB = 2 * hstepB;
    const unsigned ldsw = (unsigned)wid * 1024u;
    const int aoff = lds_byte(wr * 64 + fr, fq * 8), boff = lds_byte(wc * 32 + fr, fq * 8);
#define PG8_SA(b, h) (((b) * 2 + (h)) * HTB)
#define PG8_SB(b, h) ((4 + (b) * 2 + (h)) * HTB)
#define PG8_STAGE(bufoff, gbase, voff) do { _Pragma("unroll") for (int _i = 0; _i < 2; ++_i) \
        __builtin_amdgcn_global_load_lds((const unsigned*)((const char*)(gbase) + (voff)[_i]), (PG8_LAS unsigned*)(lds + (bufoff) + ldsw + _i * 8192), 16, 0, 0); } while (0)
#define PG8_LDA(dst, b, h) do { _Pragma("unroll") for (int m = 0; m < 4; ++m) _Pragma("unroll") for (int k = 0; k < 2; ++k) dst[m][k] = *(const PG8_LAS bf16x8*)(lds + PG8_SA(b, h) + aoff + m * 2048 + k * 1024); } while (0)
#define PG8_LDB(dst, b, h) do { _Pragma("unroll") for (int n = 0; n < 2; ++n) _Pragma("unroll") for (int k = 0; k < 2; ++k) dst[n][k] = *(const PG8_LAS bf16x8*)(lds + PG8_SB(b, h) + boff + n * 2048 + k * 1024); } while (0)
#define PG8_MMA(ai, bj, At, Bt) do { __builtin_amdgcn_s_setprio(1); _Pragma("unroll") for (int m = 0; m < 4; ++m) _Pragma("unroll") for (int n = 0; n < 2; ++n) _Pragma("unroll") for (int k = 0; k < 2; ++k) \
        acc[ai][bj][m][n] = __builtin_amdgcn_mfma_f32_16x16x32_bf16(Bt[n][k], At[m][k], acc[ai][bj][m][n], 0, 0, 0); __builtin_amdgcn_s_setprio(0); } while (0)
#define PG8_WAIT_V(n) asm volatile("s_waitcnt vmcnt(" #n ")" ::: "memory")
#define PG8_WAIT_L(n) asm volatile("s_waitcnt lgkmcnt(" #n ")" ::: "memory")
#define PG8_BAR __builtin_amdgcn_s_barrier()
#define PG8_SCHED __builtin_amdgcn_sched_barrier(0)
    Unit cur, nxt; int ui = 0;
    if (!S.next(0, cur)) return;
    f32x4 acc[2][2][4][2];
#pragma unroll
    for (int a = 0; a < 2; ++a)
#pragma unroll
        for (int b = 0; b < 2; ++b)
#pragma unroll
            for (int m = 0; m < 4; ++m)
#pragma unroll
                for (int n = 0; n < 2; ++n) acc[a][b][m][n] = (f32x4){0.f, 0.f, 0.f, 0.f};
    bf16x8 At[4][2], B0[2][2], B1[2][2];
    const char* cA = (const char*)g.A + (size_t)cur.pm * tstepA; const char* cB = (const char*)g.Bt + (size_t)cur.pn * tstepB;
    PG8_STAGE(PG8_SB(0, 0), cB, voffB); PG8_STAGE(PG8_SB(0, 1), cB + hstepB, voffB); PG8_STAGE(PG8_SA(0, 0), cA, voffA); PG8_STAGE(PG8_SA(0, 1), cA + hstepA, voffA);
    if (wr == 1) PG8_BAR;
    PG8_WAIT_V(2); PG8_BAR;
    PG8_STAGE(PG8_SB(1, 0), cB + kstep, voffB); PG8_STAGE(PG8_SA(1, 0), cA + kstep, voffA); PG8_STAGE(PG8_SB(1, 1), cB + hstepB + kstep, voffB);
    PG8_WAIT_V(6); PG8_BAR;
    for (;;) {
        const bool has_next = S.next(ui + 1, nxt);
        const char* nA = has_next ? (const char*)g.A + (size_t)nxt.pm * tstepA : cA; const char* nB = has_next ? (const char*)g.Bt + (size_t)nxt.pn * tstepB : cB;
        float pre[8]; E.prefetch(cur, wr, fr, pre);
        for (int t = 0; t < nt; t += 2) {
            const bool last = (t == nt - 2);
            const char* a1 = cA + (size_t)(t + 1) * kstep;
            const char* a2 = last ? nA : cA + (size_t)(t + 2) * kstep; const char* b2 = last ? nB : cB + (size_t)(t + 2) * kstep;
            const char* a3 = a2 + kstep; const char* b3 = b2 + kstep;
            PG8_LDB(B0, 0, 0); PG8_LDB(B1, 0, 1); PG8_SCHED; PG8_LDA(At, 0, 0); PG8_STAGE(PG8_SA(1, 1), a1 + hstepA, voffA);
            PG8_WAIT_V(8); PG8_WAIT_L(0); PG8_BAR; PG8_MMA(0, 0, At, B0); PG8_MMA(0, 1, At, B1); PG8_BAR; PG8_SCHED;
            PG8_LDA(At, 0, 1); PG8_STAGE(PG8_SB(0, 0), b2, voffB); PG8_STAGE(PG8_SB(0, 1), b2 + hstepB, voffB); PG8_STAGE(PG8_SA(0, 0), a2, voffA);
            PG8_WAIT_V(8); PG8_WAIT_L(0); PG8_BAR; PG8_MMA(1, 0, At, B0); PG8_MMA(1, 1, At, B1); PG8_BAR; PG8_SCHED;
            PG8_LDB(B0, 1, 0); PG8_LDB(B1, 1, 1); PG8_SCHED; PG8_LDA(At, 1, 0); PG8_STAGE(PG8_SA(0, 1), a2 + hstepA, voffA);
            PG8_WAIT_V(8); PG8_WAIT_L(0); PG8_BAR; PG8_MMA(0, 0, At, B0); PG8_MMA(0, 1, At, B1); PG8_BAR; PG8_SCHED;
            PG8_LDA(At, 1, 1); PG8_STAGE(PG8_SB(1, 0), b3, voffB); PG8_STAGE(PG8_SB(1, 1), b3 + hstepB, voffB); PG8_STAGE(PG8_SA(1, 0), a3, voffA);
            PG8_WAIT_V(8); PG8_WAIT_L(0); PG8_BAR; PG8_MMA(1, 0, At, B0); PG8_MMA(1, 1, At, B1); PG8_BAR; PG8_SCHED;
        }
        if (wr == 0) PG8_BAR;
        { const int tl = fresh_tid(wave_s); const int w2 = wave_s, l2 = tl & 63;
          E(acc, cur, w2 >> 2, w2 & 3, l2 & 15, l2 >> 4, pre); }
        if (!has_next) break;
#pragma unroll
        for (int a = 0; a < 2; ++a)
#pragma unroll
            for (int b = 0; b < 2; ++b)
#pragma unroll
                for (int m = 0; m < 4; ++m)
#pragma unroll
                    for (int n = 0; n < 2; ++n) acc[a][b][m][n] = (f32x4){0.f, 0.f, 0.f, 0.f};
        cur = nxt; cA = nA; cB = nB; ++ui;
        if (wr == 1) PG8_BAR;
    }
    PG8_WAIT_V(0);
    PG8_BAR;
#undef PG8_SA
#undef PG8_SB
#undef PG8_STAGE
#undef PG8_LDA
#undef PG8_LDB
#undef PG8_MMA
#undef PG8_WAIT_V
#undef PG8_WAIT_L
#undef PG8_BAR
#undef PG8_SCHED
}
}

constexpr size_t MiB = 1u << 20;
constexpr size_t WS_W = 1 * MiB;
constexpr size_t WL_GU1 = 0, WL_D1 = 11 * MiB, WL_GU2 = 17 * MiB, WL_D2 = 28 * MiB, WL_IN = 34 * MiB, WL_OUT = 38 * MiB, WL_Q = 40 * MiB, WL_KV = 40 * MiB + 512 * 1024, WL_STRIDE = 41 * MiB;
constexpr size_t WS_H = 83 * MiB;
constexpr size_t WS_F = 147 * MiB;
constexpr size_t WS_R = 211 * MiB;
constexpr size_t WS_Q = WS_R + 128 * MiB;
constexpr size_t WS_XB = 387 * MiB;
constexpr size_t WS_DS = 451 * MiB;
constexpr size_t WS_DEC = 483 * MiB;
constexpr size_t WS_CS = 484 * MiB;
constexpr size_t WS_SN = 486 * MiB;
constexpr size_t WS_SSQ = 488 * MiB;
constexpr size_t WS_SSKV = 489 * MiB;
constexpr size_t WS_RR = 489 * MiB + 512 * 1024;
constexpr size_t WS_END = 490 * MiB;
static_assert(WL_OUT + 2 * MiB <= WL_Q && WL_IN + 4 * MiB <= WL_OUT && WL_D2 + 6 * MiB <= WL_IN, "weight map");

constexpr int LDS_BYTES = 147456;
constexpr int BAR_LDS_OFF = 131072 + 256;
constexpr int WG_LDS_OFF = 131072 + 1024;
constexpr size_t WS_CTL = 0;
constexpr int NWAVES = 8;

struct Args { const void* in[24]; float* out; unsigned char* ws; int ph_lo, ph_hi; };

struct Ctx { unsigned char* lds; int tid, lane, wave, G, bid; };

__device__ __forceinline__ void transpose_item(const float* W, int K, int N, bf16_t* WT, int mode, const float* kscale, float* scr, int item, int nblk, int lane) {
    const int kb = item / nblk, nb = item % nblk, k0 = 64 * kb, n0 = 32 * nb;
    const int nn = n0 + (lane & 31);
    float wv[32];
#pragma unroll
    for (int i = 0; i < 32; ++i) { const int kk = 2 * i + (lane >> 5); wv[i] = (nn < N) ? W[(size_t)(k0 + kk) * N + nn] : 0.f; }
#pragma unroll
    for (int i = 0; i < 32; ++i) { const int kk = 2 * i + (lane >> 5); float v = wv[i]; if (kscale) v *= kscale[k0 + kk]; scr[kk * 33 + (lane & 31)] = v; }
    __builtin_amdgcn_s_waitcnt(0); asm volatile("" ::: "memory");
    const int c = lane & 7;
    int drow0 = n0; if (mode == 1) drow0 = (n0 / 128) * 256 + (n0 % 128); else if (mode == 2) drow0 = (n0 / 128) * 256 + 128 + (n0 % 128);
#pragma unroll
    for (int j = 0; j < 4; ++j) { const int n = (lane >> 3) + 8 * j; const float* s = scr + (8 * c) * 33 + n;
        u32x4 o; o.x = cvtpk(s[0 * 33], s[1 * 33]); o.y = cvtpk(s[2 * 33], s[3 * 33]); o.z = cvtpk(s[4 * 33], s[5 * 33]); o.w = cvtpk(s[6 * 33], s[7 * 33]);
        *(u32x4*)(WT + (size_t)(drow0 + n) * K + k0 + 8 * c) = o; }
    __builtin_amdgcn_s_waitcnt(0); asm volatile("" ::: "memory");
}

__device__ __forceinline__ void resnorm_phase(const Ctx& c, const bf16_t* F, const float* xin32, bf16_t* xb, float* xf32, const float* post_g, float scale, float* rr) {
    constexpr int RN = 4;
    const int gw = c.bid * NWAVES + c.wave, NGW = c.G * NWAVES;
    for (int row0 = gw * RN; row0 < T; row0 += NGW * RN) {
        f32x4 xv[RN][4]; u32x2 fw[RN][4];
#pragma unroll
        for (int q = 0; q < RN; ++q)
#pragma unroll
            for (int j = 0; j < 4; ++j) {
                const size_t off = (size_t)(row0 + q) * D + j * 256 + c.lane * 4;
                if (xin32) xv[q][j] = *(const f32x4*)(xin32 + off);
                else { const u32x2 w = *(const u32x2*)(xb + off); xv[q][j] = (f32x4){bflo(w.x), bfhi(w.x), bflo(w.y), bfhi(w.y)}; }
                if (F) fw[q][j] = *(const u32x2*)(F + off);
            }
#pragma unroll
        for (int q = 0; q < RN; ++q) {
            const int row = row0 + q;
            if (F) {
                f32x4 fv[4]; float ss = 0.f;
#pragma unroll
                for (int j = 0; j < 4; ++j) { const u32x2 w = fw[q][j]; fv[j] = (f32x4){bflo(w.x), bfhi(w.x), bflo(w.y), bfhi(w.y)};
                    ss += (fv[j][0] * fv[j][0] + fv[j][1] * fv[j][1]) + (fv[j][2] * fv[j][2] + fv[j][3] * fv[j][3]); }
                const float r = rsqrtf(wave_sum(ss) * (1.0f / D) + EPS) * scale;
#pragma unroll
                for (int j = 0; j < 4; ++j) { const f32x4 g = *(const f32x4*)(post_g + j * 256 + c.lane * 4); xv[q][j] = xv[q][j] + fv[j] * r * g; }
            }
            if (xf32) {
#pragma unroll
                for (int j = 0; j < 4; ++j) *(f32x4*)(xf32 + (size_t)row * D + j * 256 + c.lane * 4) = xv[q][j];
            } else {
#pragma unroll
                for (int j = 0; j < 4; ++j) { const f32x4 o = xv[q][j]; u32x2 w; w.x = cvtpk(o[0], o[1]); w.y = cvtpk(o[2], o[3]); *(u32x2*)(xb + (size_t)row * D + j * 256 + c.lane * 4) = w; }
            }
            if (rr) {
                float ss = 0.f;
#pragma unroll
                for (int j = 0; j < 4; ++j) ss += (xv[q][j][0] * xv[q][j][0] + xv[q][j][1] * xv[q][j][1]) + (xv[q][j][2] * xv[q][j][2] + xv[q][j][3] * xv[q][j][3]);
                const float r = rsqrtf(wave_sum(ss) * (1.0f / D) + EPS);
                if (c.lane == 0) rr[row] = r;
            }
        }
    }
}

constexpr int AT_K = 0, AT_V = 12288, AT_VP = 192, AT_BUF = 12288 + 64 * AT_VP  , AT_WS = 3 * AT_BUF;
__device__ __forceinline__ int crow(int r, int hi) { return (r & 3) + 8 * (r >> 2) + 4 * hi; }
__device__ __forceinline__ float max3f(float a, float b, float c) { float r; asm("v_max3_f32 %0, %1, %2, %3" : "=v"(r) : "v"(a), "v"(b), "v"(c)); return r; }

__device__ __forceinline__ void attn_unit(const Ctx& c, int bh, int qb, const bf16_t* Q, const bf16_t* Kb, const bf16_t* Vb, bf16_t* O) {
    const int tid = c.tid, lane = c.lane, wid = c.wave, r32 = lane & 31, hi = lane >> 5;
    const int b = bh >> 3, h = bh & 7;
    const size_t rowbase = (size_t)b * SEQ;
    const int q0 = qb * 256;
    unsigned char* lds = c.lds;
    const LAS unsigned char* ldsa = (const LAS unsigned char*)c.lds;
    float* wsf = (float*)(lds + AT_WS) + wid * 64;
    bf16x8 qr[6];
    { const bf16_t* qp = Q + (rowbase + q0 + wid * 32 + r32) * 768 + h * 96 + hi * 8;
#pragma unroll
      for (int d0 = 0; d0 < 6; ++d0) qr[d0] = *(const bf16x8*)(qp + d0 * 16); }
    const int NT = 4 * qb + 4, ntw = 4 * qb + (wid >> 1) + 1;
    const int kr0 = tid / 12, kc0 = tid % 12, kr1 = (512 + tid) / 12, kc1 = (512 + tid) % 12;
    const bf16_t* kg0 = Kb + (rowbase + kr0) * 768 + h * 96 + kc0 * 8;
    const bf16_t* kg1 = Kb + (rowbase + kr1) * 768 + h * 96 + kc1 * 8;
    const bf16_t* vg = Vb + (rowbase + (tid >> 3)) * 512 + h * 64 + (tid & 7) * 8;
    const int ks0 = AT_K + kc0 * 1024 + ((kr0 & 48) | ((kr0 ^ kc0) & 15)) * 16, ks1 = AT_K + kc1 * 1024 + ((kr1 & 48) | ((kr1 ^ kc1) & 15)) * 16;
    const int vs0 = AT_V + (tid >> 3) * AT_VP + (tid & 7) * 16;
    const int kx = r32 ^ hi;
    const int vtb = AT_V + (4 * hi + ((lane & 15) >> 2)) * AT_VP + (16 * ((lane >> 4) & 1) + 4 * (lane & 3)) * 2;
    u32x4 k0rA, k1rA, vrA, k0rB, k1rB, vrB;
#define AT_LOAD(t_, S) do { const int tc_ = (t_) < NT ? (t_) : NT - 1; const size_t off_ = (size_t)tc_ * 64; k0r##S = *(const u32x4*)(kg0 + off_ * 768); k1r##S = *(const u32x4*)(kg1 + off_ * 768); vr##S = *(const u32x4*)(vg + off_ * 512); } while (0)
#define AT_STORE(bo_, S) do { unsigned char* lb_ = lds + (bo_); *(u32x4*)(lb_ + ks0) = k0r##S; if (tid < 256) *(u32x4*)(lb_ + ks1) = k1r##S; *(u32x4*)(lb_ + vs0) = vr##S; } while (0)
#define AT_QK(P0, P1, bo_) do { const unsigned char* kb_ = lds + (bo_) + AT_K + hi * 1024 + (r32 & 16) * 16; \
        _Pragma("unroll") for (int d0 = 0; d0 < 6; ++d0) { const unsigned char* kd_ = kb_ + d0 * 2048 + ((kx ^ (2 * d0)) & 15) * 16; const bf16x8 a0_ = *(const bf16x8*)(kd_), a1_ = *(const bf16x8*)(kd_ + 512); \
            if (d0 == 0) { P0 = __builtin_amdgcn_mfma_f32_32x32x16_bf16(a0_, qr[0], f32x16{}, 0, 0, 0); P1 = __builtin_amdgcn_mfma_f32_32x32x16_bf16(a1_, qr[0], f32x16{}, 0, 0, 0); } \
            else { P0 = __builtin_amdgcn_mfma_f32_32x32x16_bf16(a0_, qr[d0], P0, 0, 0, 0); P1 = __builtin_amdgcn_mfma_f32_32x32x16_bf16(a1_, qr[d0], P1, 0, 0, 0); } } } while (0)
#define AT_MAX(C0, C1, tt_) do { \
        asm volatile("s_nop 15\n\ts_nop 2" : "+v"(C0), "+v"(C1));     \
        float ma_ = max3f(C0[0], C0[1], C0[2]), mb_ = max3f(C0[3], C1[0], C1[1]), mc_ = max3f(C1[2], C1[3], C0[4]), md_ = max3f(C0[5], C0[6], C0[7]); \
        ma_ = max3f(ma_, C1[4], C1[5]); mb_ = max3f(mb_, C1[6], C1[7]); mc_ = max3f(mc_, C0[8], C0[9]); md_ = max3f(md_, C0[10], C0[11]); \
        ma_ = max3f(ma_, C1[8], C1[9]); mb_ = max3f(mb_, C1[10], C1[11]); mc_ = max3f(mc_, C0[12], C0[13]); md_ = max3f(md_, C0[14], C0[15]); \
        ma_ = max3f(ma_, C1[12], C1[13]); mb_ = max3f(mb_, C1[14], C1[15]); \
        float mx_ = max3f(max3f(ma_, mb_, mc_), md_, md_); \
        { auto sw_ = __builtin_amdgcn_permlane32_swap(__float_as_uint(mx_), __float_as_uint(mx_), false, false); mx_ = max3f(__uint_as_float(sw_[0]), __uint_as_float(sw_[1]), mx_); }     \
        const bool upd_ = ((tt_) == 0) || (mx_ > mrow + 8.0f); \
        if (__any(upd_)) { \
            const float mn_ = upd_ ? mx_ : mrow; \
            const float alpha_ = __builtin_amdgcn_exp2f(mrow - mn_); mrow = mn_; lsum *= alpha_; \
            if (hi == 0) wsf[r32] = alpha_; \
            asm volatile("" ::: "memory"); \
            _Pragma("unroll") for (int r = 0; r < 16; ++r) { const float a_ = wsf[crow(r, hi)]; o[0][r] *= a_; o[1][r] *= a_; } \
            asm volatile("" ::: "memory"); \
        } } while (0)
#define SB_() __builtin_amdgcn_sched_barrier(0)
#define KFR_(d0_, A0, A1) do { const unsigned char* kd_ = kbn_ + (d0_) * 2048 + ((kx ^ (2 * (d0_))) & 15) * 16; A0 = *(const bf16x8*)(kd_); A1 = *(const bf16x8*)(kd_ + 512); } while (0)
#define VFR_(g_, VV) do { const LAS unsigned char* vb_ = ldsa + b0 + vtb + ((g_) & 1) * 64 + ((g_) >> 1) * 16 * AT_VP; \
        const u32x2 lo_ = __builtin_bit_cast(u32x2, __builtin_amdgcn_ds_read_tr16_b64_v4i16((LAS v4i16_t*)(vb_))), hh_ = __builtin_bit_cast(u32x2, __builtin_amdgcn_ds_read_tr16_b64_v4i16((LAS v4i16_t*)(vb_ + 8 * AT_VP))); \
        VV = (u32x4){lo_.x, lo_.y, hh_.x, hh_.y}; } while (0)
#define EX_(P, r) P[r] = __builtin_amdgcn_exp2f(P[r] - mrow)
#define AT_FAST(C0, C1, N0, N1) do { \
        const unsigned char* kbn_ = lds + b1 + AT_K + hi * 1024 + (r32 & 16) * 16; \
        bf16x8 ka0_, ka1_, kb0_, kb1_; u32x4 pw0_, pw1_, pw2_, pw3_, va_, vb2_; float ps_ = 0.f; \
        KFR_(0, ka0_, ka1_); SB_(); \
          \
        KFR_(1, kb0_, kb1_); N0 = __builtin_amdgcn_mfma_f32_32x32x16_bf16(ka0_, qr[0], f32x16{}, 0, 0, 0); EX_(C0, 0); EX_(C0, 1); SB_(); \
        N1 = __builtin_amdgcn_mfma_f32_32x32x16_bf16(ka1_, qr[0], f32x16{}, 0, 0, 0); EX_(C0, 2); EX_(C0, 3); SB_(); \
        KFR_(2, ka0_, ka1_); N0 = __builtin_amdgcn_mfma_f32_32x32x16_bf16(kb0_, qr[1], N0, 0, 0, 0); EX_(C0, 4); EX_(C0, 5); SB_(); \
        N1 = __builtin_amdgcn_mfma_f32_32x32x16_bf16(kb1_, qr[1], N1, 0, 0, 0); EX_(C0, 6); EX_(C0, 7); SB_(); \
        KFR_(3, kb0_, kb1_); N0 = __builtin_amdgcn_mfma_f32_32x32x16_bf16(ka0_, qr[2], N0, 0, 0, 0); EX_(C0, 8); EX_(C0, 9); SB_(); \
        N1 = __builtin_amdgcn_mfma_f32_32x32x16_bf16(ka1_, qr[2], N1, 0, 0, 0); EX_(C0, 10); EX_(C0, 11); SB_(); \
        KFR_(4, ka0_, ka1_); N0 = __builtin_amdgcn_mfma_f32_32x32x16_bf16(kb0_, qr[3], N0, 0, 0, 0); EX_(C0, 12); EX_(C0, 13); SB_(); \
        N1 = __builtin_amdgcn_mfma_f32_32x32x16_bf16(kb1_, qr[3], N1, 0, 0, 0); EX_(C0, 14); EX_(C0, 15); SB_(); \
        KFR_(5, kb0_, kb1_); N0 = __builtin_amdgcn_mfma_f32_32x32x16_bf16(ka0_, qr[4], N0, 0, 0, 0); ps_ += (C0[0] + C0[1]) + (C0[2] + C0[3]); pw0_.x = cvtpk(C0[0], C0[1]); pw0_.y = cvtpk(C0[2], C0[3]); SB_(); \
        N1 = __builtin_amdgcn_mfma_f32_32x32x16_bf16(ka1_, qr[4], N1, 0, 0, 0); ps_ += (C0[4] + C0[5]) + (C0[6] + C0[7]); pw0_.z = cvtpk(C0[4], C0[5]); pw0_.w = cvtpk(C0[6], C0[7]); SB_(); \
        VFR_(0, va_); N0 = __builtin_amdgcn_mfma_f32_32x32x16_bf16(kb0_, qr[5], N0, 0, 0, 0); ps_ += (C0[8] + C0[9]) + (C0[10] + C0[11]); pw1_.x = cvtpk(C0[8], C0[9]); pw1_.y = cvtpk(C0[10], C0[11]); SB_(); \
        VFR_(1, vb2_); N1 = __builtin_amdgcn_mfma_f32_32x32x16_bf16(kb1_, qr[5], N1, 0, 0, 0); ps_ += (C0[12] + C0[13]) + (C0[14] + C0[15]); pw1_.z = cvtpk(C0[12], C0[13]); pw1_.w = cvtpk(C0[14], C0[15]); SB_(); \
          \
        o[0] = __builtin_amdgcn_mfma_f32_32x32x16_bf16(__builtin_bit_cast(bf16x8, pw0_), __builtin_bit_cast(bf16x8, va_), o[0], 0, 0, 0); VFR_(2, va_); EX_(C1, 0); EX_(C1, 1); EX_(C1, 2); EX_(C1, 3); SB_(); \
        o[1] = __builtin_amdgcn_mfma_f32_32x32x16_bf16(__builtin_bit_cast(bf16x8, pw0_), __builtin_bit_cast(bf16x8, vb2_), o[1], 0, 0, 0); VFR_(3, vb2_); EX_(C1, 4); EX_(C1, 5); EX_(C1, 6); EX_(C1, 7); SB_(); \
        o[0] = __builtin_amdgcn_mfma_f32_32x32x16_bf16(__builtin_bit_cast(bf16x8, pw1_), __builtin_bit_cast(bf16x8, va_), o[0], 0, 0, 0); VFR_(4, va_); EX_(C1, 8); EX_(C1, 9); EX_(C1, 10); EX_(C1, 11); pw2_.x = cvtpk(C1[0], C1[1]); pw2_.y = cvtpk(C1[2], C1[3]); SB_(); \
        o[1] = __builtin_amdgcn_mfma_f32_32x32x16_bf16(__builtin_bit_cast(bf16x8, pw1_), __builtin_bit_cast(bf16x8, vb2_), o[1], 0, 0, 0); VFR_(5, vb2_); EX_(C1, 12); EX_(C1, 13); EX_(C1, 14); EX_(C1, 15); pw2_.z = cvtpk(C1[4], C1[5]); pw2_.w = cvtpk(C1[6], C1[7]); SB_(); \
        o[0] = __builtin_amdgcn_mfma_f32_32x32x16_bf16(__builtin_bit_cast(bf16x8, pw2_), __builtin_bit_cast(bf16x8, va_), o[0], 0, 0, 0); VFR_(6, va_); ps_ += (C1[0] + C1[1]) + (C1[2] + C1[3]); pw3_.x = cvtpk(C1[8], C1[9]); pw3_.y = cvtpk(C1[10], C1[11]); SB_(); \
        o[1] = __builtin_amdgcn_mfma_f32_32x32x16_bf16(__builtin_bit_cast(bf16x8, pw2_), __builtin_bit_cast(bf16x8, vb2_), o[1], 0, 0, 0); VFR_(7, vb2_); ps_ += (C1[4] + C1[5]) + (C1[6] + C1[7]); pw3_.z = cvtpk(C1[12], C1[13]); pw3_.w = cvtpk(C1[14], C1[15]); SB_(); \
        o[0] = __builtin_amdgcn_mfma_f32_32x32x16_bf16(__builtin_bit_cast(bf16x8, pw3_), __builtin_bit_cast(bf16x8, va_), o[0], 0, 0, 0); ps_ += (C1[8] + C1[9]) + (C1[10] + C1[11]); SB_(); \
        o[1] = __builtin_amdgcn_mfma_f32_32x32x16_bf16(__builtin_bit_cast(bf16x8, pw3_), __builtin_bit_cast(bf16x8, vb2_), o[1], 0, 0, 0); ps_ += (C1[12] + C1[13]) + (C1[14] + C1[15]); SB_(); \
        lsum += ps_; } while (0)
#define AT_STEP(C0, C1, N0, N1, t_, S) do { const int tt_ = (t_); \
        AT_STORE(b2, S);                        \
        AT_LOAD(tt_ + 4, S); \
        if (tt_ < ntw) {          \
            AT_MAX(C0, C1, tt_); \
            AT_FAST(C0, C1, N0, N1); \
        } \
        asm volatile("s_waitcnt lgkmcnt(0)" ::: "memory"); __builtin_amdgcn_s_barrier(); asm volatile("" ::: "memory");     \
        { const int tb_ = b0; b0 = b1; b1 = b2; b2 = tb_; } } while (0)

    int b0 = 0, b1 = AT_BUF, b2 = 2 * AT_BUF;
    float mrow = -1e30f, lsum = 0.f;
    f32x16 o[2]; o[0] = f32x16{}; o[1] = f32x16{};
    AT_LOAD(0, A); AT_LOAD(1, B); AT_STORE(b0, A); AT_LOAD(2, A); AT_STORE(b1, B); AT_LOAD(3, B);
    __syncthreads();
    f32x16 pA0, pA1, pB0, pB1;
    AT_QK(pA0, pA1, b0);
    for (int t = 0; t < NT; t += 2) {
        AT_STEP(pA0, pA1, pB0, pB1, t, A);
        AT_STEP(pB0, pB1, pA0, pA1, t + 1, B);
    }
#undef AT_LOAD
#undef AT_STORE
#undef AT_QK
#undef AT_FAST
#undef SB_
#undef KFR_
#undef VFR_
#undef EX_
#undef AT_MAX
#undef AT_STEP
    { auto sw_ = __builtin_amdgcn_permlane32_swap(__float_as_uint(lsum), __float_as_uint(lsum), false, false); lsum = __uint_as_float(sw_[0]) + __uint_as_float(sw_[1]); }
    if (hi == 0) wsf[r32] = 1.0f / lsum;
    asm volatile("" ::: "memory");
    bf16_t* op = O + (rowbase + q0 + wid * 32) * 1024 + h * 64 + r32;
#pragma unroll
    for (int r = 0; r < 16; ++r) { const int qq = crow(r, hi); const float rl = wsf[qq];
        op[(size_t)qq * 1024] = (bf16_t)(cvtpk(o[0][r] * rl, 0.f) & 0xffffu); op[(size_t)qq * 1024 + 32] = (bf16_t)(cvtpk(o[1][r] * rl, 0.f) & 0xffffu); }
    asm volatile("" ::: "memory");
}

constexpr int GP = 144;
struct ChunkIn { const bf16_t* proj; const float* wgu; const float* bg; const float* cs; const float* sn; };

struct ChunkRaw { u32x2 qa, qb, ka, kb; u32x4 g0, g1; f32x4 cc, ss; };
template <bool GLA>
__device__ __forceinline__ void chunk_load(const ChunkIn& ci, int t, int h, int kq, ChunkRaw& r) {
    const bf16_t* pr = ci.proj + (size_t)t * DINP;
    const int cq = GLA ? C_GQ : C_RQ, ck = GLA ? C_GK : C_RK;
    r.qa = *(const u32x2*)(pr + cq + h * 32 + 4 * kq); r.qb = *(const u32x2*)(pr + cq + h * 32 + 16 + 4 * kq);
    r.ka = *(const u32x2*)(pr + ck + h * 32 + 4 * kq); r.kb = *(const u32x2*)(pr + ck + h * 32 + 16 + 4 * kq);
    if (GLA) { r.g0 = *(const u32x4*)(pr + C_GG); r.g1 = *(const u32x4*)(pr + C_GG + 8); }
    else { r.cc = *(const f32x4*)(ci.cs + (size_t)t * 16 + 4 * kq); r.ss = *(const f32x4*)(ci.sn + (size_t)t * 16 + 4 * kq); }
}
template <bool GLA>
__device__ __forceinline__ void chunk_tile(const ChunkRaw& raw, const bf16x8 (&wfr)[2], const f32x4 (&bfr)[2], int h, int it, int row, int kq, float lg, float (&carry)[8], float (&bq)[8], float (&qv)[8], float (&kv)[8]) {
    const u32x2 qa = raw.qa, qb = raw.qb, ka = raw.ka, kb = raw.kb;
    float q[8] = {bflo(qa.x), bfhi(qa.x), bflo(qa.y), bfhi(qa.y), bflo(qb.x), bfhi(qb.x), bflo(qb.y), bfhi(qb.y)};
    float k[8] = {bflo(ka.x), bfhi(ka.x), bflo(ka.y), bfhi(ka.y), bflo(kb.x), bfhi(kb.x), bflo(kb.y), bfhi(kb.y)};
    const float qs = 0.17677669529663687f;
    if (GLA) {
        const u32x4 gsel = (kq == 0) ? raw.g0 : (kq == 1) ? raw.g1 : (u32x4){0u, 0u, 0u, 0u};
        const bf16x8 gfr = __builtin_bit_cast(bf16x8, gsel);
        const f32x4 z0 = __builtin_amdgcn_mfma_f32_16x16x32_bf16(wfr[0], gfr, bfr[0], 0, 0, 0), z1 = __builtin_amdgcn_mfma_f32_16x16x32_bf16(wfr[1], gfr, bfr[1], 0, 0, 0);
        const float z[8] = {z0[0], z0[1], z0[2], z0[3], z1[0], z1[1], z1[2], z1[3]};
#pragma unroll
        for (int j = 0; j < 8; ++j) {
            float la = (fminf(z[j], 0.f) - __logf(1.0f + __expf(-fabsf(z[j])))) * (1.0f / 16.0f);
            la += __int_as_float(__builtin_amdgcn_update_dpp(0, __float_as_int(la), 0x111, 0xf, 0xf, false));
            la += __int_as_float(__builtin_amdgcn_update_dpp(0, __float_as_int(la), 0x112, 0xf, 0xf, false));
            la += __int_as_float(__builtin_amdgcn_update_dpp(0, __float_as_int(la), 0x114, 0xf, 0xf, false));
            la += __int_as_float(__builtin_amdgcn_update_dpp(0, __float_as_int(la), 0x118, 0xf, 0xf, false));
            bq[j] = la + carry[j];
            carry[j] += __int_as_float(__builtin_amdgcn_ds_bpermute((16 * kq + 15) * 4, __float_as_int(la)));
            qv[j] = q[j] * qs; kv[j] = k[j];
        }
    } else {
        const f32x4 cc = raw.cc, ss = raw.ss;
#pragma unroll
        for (int j = 0; j < 4; ++j) {
            qv[j] = (q[j] * cc[j] - q[4 + j] * ss[j]) * qs; qv[4 + j] = (q[j] * ss[j] + q[4 + j] * cc[j]) * qs;
            kv[j] = k[j] * cc[j] - k[4 + j] * ss[j];        kv[4 + j] = k[j] * ss[j] + k[4 + j] * cc[j];
        }
#pragma unroll
        for (int j = 0; j < 8; ++j) { bq[j] = (float)(16 * it + row + 1) * lg; carry[j] = 64.0f * lg; }
    }
}

__device__ __forceinline__ void chunk_gate_frags(const float* wgl, int h, int row, int kq, bf16x8 (&wfr)[2], f32x4 (&bfr)[2]) {
#pragma unroll
    for (int nt = 0; nt < 2; ++nt) {
        float w[8];
#pragma unroll
        for (int j = 0; j < 8; ++j) w[j] = (kq < 2) ? wgl[(8 * (kq & 1) + j) * 128 + h * 32 + 16 * nt + row] : 0.f;
        wfr[nt] = __builtin_bit_cast(bf16x8, (u32x4){cvtpk(w[0], w[1]), cvtpk(w[2], w[3]), cvtpk(w[4], w[5]), cvtpk(w[6], w[7])});
        bfr[nt] = *(const f32x4*)(wgl + 2048 + h * 32 + 16 * nt + 4 * kq);
    }
}

__device__ __forceinline__ void chunk_load_vt(const bf16_t* proj, int t0, int vcol, unsigned char* wl, int lane) {
    const bf16_t* vp = proj + (size_t)(t0 + lane) * DINP + vcol;
#pragma unroll
    for (int cidx = 0; cidx < 8; ++cidx) {
        const u32x4 v = *(const u32x4*)(vp + cidx * 8);
        const unsigned w4[4] = {v.x, v.y, v.z, v.w};
#pragma unroll
        for (int j = 0; j < 4; ++j) {
            *(bf16_t*)(wl + (cidx * 8 + 2 * j) * GP + lane * 2) = (bf16_t)(w4[j] & 0xffffu);
            *(bf16_t*)(wl + (cidx * 8 + 2 * j + 1) * GP + lane * 2) = (bf16_t)(w4[j] >> 16);
        }
    }
}

template <bool GLA>
__device__ __forceinline__ void chunk_pass_a(const ChunkIn& ci, const float* wgl, int unit, unsigned char* wl, int lane, float* dS, float* dec) {
    const int h = unit & 3, bn = unit >> 2, t0 = bn * 64;
    const int row = lane & 15, kq = lane >> 4;
    float carry[8] = {0.f, 0.f, 0.f, 0.f, 0.f, 0.f, 0.f, 0.f};
    float bq[4][8], kk[4][8];
    int hh_ = h; asm volatile("" : "+s"(hh_)); const float hf = (float)hh_;
    const float lg = GLA ? 0.f : __logf(1.0f - __builtin_amdgcn_exp2f(-5.0f - hf));
    ChunkRaw raw[4];
#pragma unroll
    for (int it = 0; it < 4; ++it) chunk_load<GLA>(ci, t0 + 16 * it + row, h, kq, raw[it]);
    bf16x8 wfr[2]; f32x4 bfr[2]; if (GLA) chunk_gate_frags(wgl, h, row, kq, wfr, bfr);
#pragma unroll
    for (int it = 0; it < 4; ++it) { float qv[8]; chunk_tile<GLA>(raw[it], wfr, bfr, h, it, row, kq, lg, carry, bq[it], qv, kk[it]); }
    unsigned char* kst = wl + 64 * GP;
#pragma unroll
    for (int it = 0; it < 4; ++it)
#pragma unroll
        for (int j = 0; j < 8; ++j) {
            const int d = (j < 4) ? (4 * kq + j) : (16 + 4 * kq + (j - 4));
            const float ks = kk[it][j] * __expf(carry[j] - bq[it][j]);
            *(bf16_t*)(kst + d * GP + (16 * it + row) * 2) = (bf16_t)(cvtpk(ks, 0.f) & 0xffffu);
        }
    chunk_load_vt(ci.proj, t0, (GLA ? C_GV : C_RV) + h * 64, wl, lane);
    __builtin_amdgcn_s_waitcnt(0); asm volatile("" ::: "memory");
    float* out = dS + (size_t)unit * 2048;
#pragma unroll
    for (int dt = 0; dt < 2; ++dt)
#pragma unroll
        for (int et = 0; et < 4; ++et) {
            f32x4 acc = {0.f, 0.f, 0.f, 0.f};
#pragma unroll
            for (int ks = 0; ks < 2; ++ks) {
                const bf16x8 a = *(const bf16x8*)(kst + (16 * dt + row) * GP + (32 * ks + 8 * kq) * 2);
                const bf16x8 bb = *(const bf16x8*)(wl + (16 * et + row) * GP + (32 * ks + 8 * kq) * 2);
                acc = __builtin_amdgcn_mfma_f32_16x16x32_bf16(a, bb, acc, 0, 0, 0);
            }
#pragma unroll
            for (int r = 0; r < 4; ++r) out[(16 * dt + 4 * kq + r) * 64 + 16 * et + row] = acc[r];
        }
    if (row == 0) {
#pragma unroll
        for (int j = 0; j < 8; ++j) { const int d = (j < 4) ? (4 * kq + j) : (16 + 4 * kq + (j - 4)); dec[(size_t)unit * 32 + d] = __expf(carry[j]); }
    }
    __builtin_amdgcn_s_waitcnt(0); asm volatile("" ::: "memory");
}

template <bool GLA>
__device__ __forceinline__ void chunk_pass_c(const ChunkIn& ci, const float* wgl, int unit, unsigned char* wl, int lane, const float* Sb, const float* ng, bf16_t* omix) {
    const int h = unit & 3, bn = unit >> 2, t0 = bn * 64;
    const int row = lane & 15, kq = lane >> 4;
    chunk_load_vt(ci.proj, t0, (GLA ? C_GV : C_RV) + h * 64, wl, lane);
    unsigned char* sst = wl + 64 * GP;
    { const float* sp = Sb + (size_t)unit * 2048 + lane;
      float sv[32];
#pragma unroll
      for (int d = 0; d < 32; ++d) sv[d] = sp[d * 64];
#pragma unroll
      for (int q4 = 0; q4 < 4; ++q4) {
          u32x4 w; w.x = cvtpk(sv[4 * q4 + 0], sv[4 * q4 + 1]); w.y = cvtpk(sv[4 * q4 + 2], sv[4 * q4 + 3]); w.z = cvtpk(sv[16 + 4 * q4 + 0], sv[16 + 4 * q4 + 1]); w.w = cvtpk(sv[16 + 4 * q4 + 2], sv[16 + 4 * q4 + 3]);
          *(u32x4*)(sst + lane * 64 + q4 * 16) = w;
      } }
    asm volatile("" ::: "memory");
    float carry[8] = {0.f, 0.f, 0.f, 0.f, 0.f, 0.f, 0.f, 0.f};
    int hh_ = h; asm volatile("" : "+s"(hh_)); const float hf = (float)hh_;
    const float lg = GLA ? 0.f : __logf(1.0f - __builtin_amdgcn_exp2f(-5.0f - hf));
    bf16x8 qf[4], kf[4], qb[4], kb[4];
    ChunkRaw raw[4];
#pragma unroll
    for (int it = 0; it < 4; ++it) chunk_load<GLA>(ci, t0 + 16 * it + row, h, kq, raw[it]);
    bf16x8 wfr[2]; f32x4 bfr[2]; if (GLA) chunk_gate_frags(wgl, h, row, kq, wfr, bfr);
#pragma unroll
    for (int it = 0; it < 4; ++it) {
        float bq[8], qv[8], kv[8];
        chunk_tile<GLA>(raw[it], wfr, bfr, h, it, row, kq, lg, carry, bq, qv, kv);
        float a[8], bneg[8], cpos[8], dneg[8];
#pragma unroll
        for (int j = 0; j < 8; ++j) { const float eb = __expf(bq[j]), enb = __expf(-bq[j]); a[j] = qv[j] * eb; bneg[j] = kv[j] * enb; cpos[j] = qv[j] * enb; dneg[j] = kv[j] * eb; }
        qf[it] = __builtin_bit_cast(bf16x8, (u32x4){cvtpk(a[0], a[1]), cvtpk(a[2], a[3]), cvtpk(a[4], a[5]), cvtpk(a[6], a[7])});
        kf[it] = __builtin_bit_cast(bf16x8, (u32x4){cvtpk(bneg[0], bneg[1]), cvtpk(bneg[2], bneg[3]), cvtpk(bneg[4], bneg[5]), cvtpk(bneg[6], bneg[7])});
        qb[it] = __builtin_bit_cast(bf16x8, (u32x4){cvtpk(cpos[0], cpos[1]), cvtpk(cpos[2], cpos[3]), cvtpk(cpos[4], cpos[5]), cvtpk(cpos[6], cpos[7])});
        kb[it] = __builtin_bit_cast(bf16x8, (u32x4){cvtpk(dneg[0], dneg[1]), cvtpk(dneg[2], dneg[3]), cvtpk(dneg[4], dneg[5]), cvtpk(dneg[6], dneg[7])});
        asm volatile("" ::: "memory");
    }
    __builtin_amdgcn_s_waitcnt(0); asm volatile("" ::: "memory");
    bf16x8 vfr[4][2], sfr[4];
#pragma unroll
    for (int et = 0; et < 4; ++et) {
#pragma unroll
        for (int p = 0; p < 2; ++p) {
            const u32x2 lo = *(const u32x2*)(wl + (16 * et + row) * GP + (32 * p + 4 * kq) * 2), hh = *(const u32x2*)(wl + (16 * et + row) * GP + (32 * p + 16 + 4 * kq) * 2);
            vfr[et][p] = __builtin_bit_cast(bf16x8, (u32x4){lo.x, lo.y, hh.x, hh.y});
        }
        sfr[et] = *(const bf16x8*)(sst + (16 * et + row) * 64 + kq * 16);
    }
    const int gcol = (GLA ? C_GR : C_RG) + h * 64, ocol = (GLA ? 512 : 768) + h * 64;
    float gn[4];
#pragma unroll
    for (int et = 0; et < 4; ++et) gn[et] = ng[16 * et + row];
#pragma unroll
    for (int it = 0; it < 4; ++it) {
        f32x4 st[4];
#pragma unroll
        for (int jt = 0; jt < 4; ++jt) {
            const f32x4 z = {0.f, 0.f, 0.f, 0.f};
            if (jt < it) st[jt] = __builtin_amdgcn_mfma_f32_16x16x32_bf16(kf[jt], qf[it], z, 0, 0, 0);
            else if (jt > it) st[jt] = __builtin_amdgcn_mfma_f32_16x16x32_bf16(kb[jt], qb[it], z, 0, 0, 0);
            else {
                const f32x4 lo = __builtin_amdgcn_mfma_f32_16x16x32_bf16(kf[jt], qf[it], z, 0, 0, 0), up = __builtin_amdgcn_mfma_f32_16x16x32_bf16(kb[jt], qb[it], z, 0, 0, 0);
#pragma unroll
                for (int r = 0; r < 4; ++r) st[jt][r] = (4 * kq + r <= row) ? lo[r] : up[r];
            }
        }
        bf16x8 af[2];
#pragma unroll
        for (int p = 0; p < 2; ++p)
            af[p] = __builtin_bit_cast(bf16x8, (u32x4){cvtpk(st[2 * p][0], st[2 * p][1]), cvtpk(st[2 * p][2], st[2 * p][3]), cvtpk(st[2 * p + 1][0], st[2 * p + 1][1]), cvtpk(st[2 * p + 1][2], st[2 * p + 1][3])});
        f32x4 o[4]; float ss[4] = {0.f, 0.f, 0.f, 0.f};
#pragma unroll
        for (int et = 0; et < 4; ++et) {
            f32x4 acc = {0.f, 0.f, 0.f, 0.f};
            acc = __builtin_amdgcn_mfma_f32_16x16x32_bf16(af[0], vfr[et][0], acc, 0, 0, 0);
            acc = __builtin_amdgcn_mfma_f32_16x16x32_bf16(af[1], vfr[et][1], acc, 0, 0, 0);
            acc = __builtin_amdgcn_mfma_f32_16x16x32_bf16(qf[it], sfr[et], acc, 0, 0, 0);
            o[et] = acc;
#pragma unroll
            for (int r = 0; r < 4; ++r) ss[r] += acc[r] * acc[r];
        }
#pragma unroll
        for (int r = 0; r < 4; ++r) {
            ss[r] += swz_xor<1>(ss[r]); ss[r] += swz_xor<2>(ss[r]); ss[r] += swz_xor<4>(ss[r]); ss[r] += swz_xor<8>(ss[r]);
            const float rs = rsqrtf(ss[r] * (1.0f / 64.0f) + EPS);
            const int t = t0 + 16 * it + 4 * kq + r;
#pragma unroll
            for (int et = 0; et < 4; ++et) {
                const int e = 16 * et + row;
                const float gt = __uint_as_float((unsigned)ci.proj[(size_t)t * DINP + gcol + e] << 16);
                const float val = o[et][r] * rs * gn[et] * pg8::silu_f(gt);
                omix[(size_t)t * 1024 + ocol + e] = (bf16_t)(cvtpk(val, 0.f) & 0xffffu);
            }
        }
    }
    __builtin_amdgcn_s_waitcnt(0); asm volatile("" ::: "memory");
}

#define XB_TMO      128
#define XB_XCNT(j)  (256  + 64 * (j))
#define XB_XSUB(j)  (1280 + 64 * (j))
#define XB_XGEN(j)  (2304 + 64 * (j))
#define XB_TOP      3328
#define XB_TOPGEN   3392
#define XCD_BAR_WORDS 3456
#define XB_SPIN_CAP (1u << 18)

__device__ __forceinline__ unsigned xb_ld(unsigned* p)              { return __hip_atomic_load(p, __ATOMIC_RELAXED, __HIP_MEMORY_SCOPE_AGENT); }
__device__ __forceinline__ unsigned xb_add(unsigned* p, unsigned v) { return __hip_atomic_fetch_add(p, v, __ATOMIC_RELAXED, __HIP_MEMORY_SCOPE_AGENT); }
__device__ __forceinline__ unsigned xb_xcc_id() { return (unsigned)__builtin_amdgcn_s_getreg((3 << 11) | 20) & 0xFu; }
#define XB_SPIN(cond, bar) do { unsigned _sp = 0; while (cond) { __builtin_amdgcn_s_sleep(1); \
    if ((++_sp & 255u) == 0u) { if (xb_ld(&(bar)[XB_TMO])) break; if (_sp > XB_SPIN_CAP) { atomicAdd(&(bar)[XB_TMO], 1u); break; } } } } while (0)

struct XcdBarrier {
    unsigned* bar; unsigned x;
    volatile LAS unsigned* st;
};

__device__ __forceinline__ XcdBarrier xcd_barrier_post(unsigned* bar, volatile LAS unsigned* st) {
    XcdBarrier b; b.bar = bar; b.x = xb_xcc_id(); b.st = st;
    if (threadIdx.x == 0) (void)xb_add(&bar[XB_XCNT(b.x)], 1u);
    return b;
}
__device__ __forceinline__ void xcd_barrier_complete(unsigned* bar, unsigned x, unsigned& nloc, unsigned& nx) {
    const unsigned G = gridDim.x * gridDim.y * gridDim.z;
    unsigned sum, cnt, mine, sp = 0u;
    for (;;) {
        sum = 0u; cnt = 0u; mine = 0u;
#pragma unroll
        for (unsigned j = 0; j < 16; ++j) { const unsigned c = xb_ld(&bar[XB_XCNT(j)]); sum += c; cnt += (c > 0u) ? 1u : 0u; mine = (j == x) ? c : mine; }
        if (sum == G) break;
        __builtin_amdgcn_s_sleep(1);
        if ((++sp & 255u) == 0u) { if (xb_ld(&bar[XB_TMO])) break; if (sp > XB_SPIN_CAP) { atomicAdd(&bar[XB_TMO], 1u); break; } }
    }
    nloc = mine > 0u ? mine : 1u; nx = cnt > 0u ? cnt : 1u;
}

__device__ __forceinline__ void xcd_barrier(const XcdBarrier& b) {
    asm volatile("s_waitcnt vmcnt(0)" ::: "memory");
    __syncthreads();
    if (threadIdx.x == 0) {
        unsigned* bar = b.bar;
        __builtin_amdgcn_s_waitcnt(0);
        unsigned nloc = b.st[0], nx = b.st[1];
        if (nloc == 0u) { xcd_barrier_complete(bar, b.x, nloc, nx); b.st[0] = nloc; b.st[1] = nx; }
        const unsigned old = xb_add(&bar[XB_XSUB(b.x)], 1u);
        const unsigned gen = old / nloc;
        if (old + 1u == (gen + 1u) * nloc) {
            __builtin_amdgcn_fence(__ATOMIC_RELEASE, "agent");
            asm volatile("s_waitcnt vmcnt(0)" ::: "memory");
            const unsigned og = xb_add(&bar[XB_TOP], 1u);
            const unsigned tg = og / nx;
            if (og + 1u == (tg + 1u) * nx) xb_add(&bar[XB_TOPGEN], 1u);
            else XB_SPIN(xb_ld(&bar[XB_TOPGEN]) == tg, bar);
            __builtin_amdgcn_fence(__ATOMIC_ACQUIRE, "agent");
            xb_add(&bar[XB_XGEN(b.x)], 1u);
            asm volatile("s_waitcnt vmcnt(0)" ::: "memory");
        } else {
            XB_SPIN(xb_ld(&bar[XB_XGEN(b.x)]) == gen, bar);
            __builtin_amdgcn_fence(__ATOMIC_ACQUIRE, "agent");
            asm volatile("s_waitcnt vmcnt(0)" ::: "memory");
        }
    }
    __syncthreads();
}


__global__ void __launch_bounds__(NWAVES * 64, 2) mega_fwd(Args args) {
    extern __shared__ __attribute__((aligned(16))) unsigned char lds[];
    const int lo = args.ph_lo, hi = args.ph_hi;
    const int wave_s = __builtin_amdgcn_readfirstlane((int)threadIdx.x >> 6);
    volatile LAS unsigned* bst = (volatile LAS unsigned*)((LAS unsigned char*)lds + BAR_LDS_OFF);
    if (threadIdx.x < 4) bst[threadIdx.x] = 0u;
    __syncthreads();
    XcdBarrier xbar = xcd_barrier_post((unsigned*)(args.ws + WS_CTL) + 64, bst);
#define WPTR(l, off) ((bf16_t*)(ws + WS_W + (size_t)(l) * WL_STRIDE + (off)))
#define INF(i, l, n) ((const float*)ap->in[i] + (size_t)(l) * (n))

    for (int ph = lo; ph < hi; ++ph) {
        { const int sp_ = (ph > 0) ? (ph - 1) % 12 : -1; if (sp_ == 2 || sp_ == 8 || sp_ == 11) continue; }
        if (ph > lo) { if (hi > (1 << 20)) cg::this_grid().sync(); else xcd_barrier(xbar); }
        const __attribute__((address_space(4))) Args* ap = (const __attribute__((address_space(4))) Args*)__builtin_amdgcn_kernarg_segment_ptr(); asm volatile("" : "+s"(ap));
        Ctx c; c.lds = lds; c.tid = 0; c.lane = 0; c.wave = wave_s; { int g_ = gridDim.x, b_ = blockIdx.x; asm volatile("" : "+s"(g_), "+s"(b_)); c.G = g_; c.bid = b_; }
#define FRESH_CTX() do { c.tid = fresh_tid(wave_s); c.lane = c.tid & 63; } while (0)
        unsigned char* ws = ap->ws;
        bf16_t* xb = (bf16_t*)(ws + WS_XB); float* rrow = (float*)(ws + WS_RR);
        float* xch = (float*)(ws + WS_F + 48 * MiB);
        bf16_t* Hb = (bf16_t*)(ws + WS_H); bf16_t* Fb = (bf16_t*)(ws + WS_F); bf16_t* Rb = (bf16_t*)(ws + WS_R); bf16_t* Qb = (bf16_t*)(ws + WS_Q);
        bf16_t* Kbuf = Hb; bf16_t* Vbuf = Fb; bf16_t* proj = Rb; bf16_t* omix = (bf16_t*)ap->out;
        float* dS = (float*)(ws + WS_DS); float* dec = (float*)(ws + WS_DEC); float* cs = (float*)(ws + WS_CS); float* sn = (float*)(ws + WS_SN);
        float* ssq = (float*)(ws + WS_SSQ); float* sskv = (float*)(ws + WS_SSKV);
        const int gw = c.bid * NWAVES + c.wave, NGW = c.G * NWAVES;
        PG8_LAS unsigned char* ldsl = (PG8_LAS unsigned char*)lds;
        if (ph == 0) {
            FRESH_CTX();
            float* scr = (float*)(lds + c.wave * 16384);
            constexpr int I_G = 16 * 88, I_D = 44 * 32, I_IN = 16 * 64, I_Q = 4 * 24, I_KV = 2 * 32, I_O = 16 * 32;
            constexpr int PER_L = 6 * I_G + I_IN + I_Q + I_KV + I_O;
            static_assert(I_G == I_D, "items");
            for (int it = gw; it < 2 * PER_L; it += NGW) {
                const int l = it / PER_L; int r = it % PER_L;
                if (r < I_G) { transpose_item(INF(4, l, D * FF), D, FF, WPTR(l, WL_GU1), 1, INF(2, l, D), scr, r, 88, c.lane); continue; } r -= I_G;
                if (r < I_G) { transpose_item(INF(5, l, D * FF), D, FF, WPTR(l, WL_GU1), 2, INF(2, l, D), scr, r, 88, c.lane); continue; } r -= I_G;
                if (r < I_D) { transpose_item(INF(6, l, D * FF), FF, D, WPTR(l, WL_D1), 0, nullptr, scr, r, 32, c.lane); continue; } r -= I_D;
                if (r < I_G) { transpose_item(INF(21, l, D * FF), D, FF, WPTR(l, WL_GU2), 1, INF(19, l, D), scr, r, 88, c.lane); continue; } r -= I_G;
                if (r < I_G) { transpose_item(INF(22, l, D * FF), D, FF, WPTR(l, WL_GU2), 2, INF(19, l, D), scr, r, 88, c.lane); continue; } r -= I_G;
                if (r < I_D) { transpose_item(INF(23, l, D * FF), FF, D, WPTR(l, WL_D2), 0, nullptr, scr, r, 32, c.lane); continue; } r -= I_D;
                if (r < I_IN) { transpose_item(INF(9, l, D * DIN), D, DIN, WPTR(l, WL_IN), 0, INF(7, l, D), scr, r, 64, c.lane); continue; } r -= I_IN;
                if (r < I_Q) { transpose_item(INF(11, l, 256 * 768), 256, 768, WPTR(l, WL_Q), 0, INF(10, l, 256), scr, r, 24, c.lane); continue; } r -= I_Q;
                if (r < I_KV) { transpose_item(INF(13, l, 128 * 1024), 128, 1024, WPTR(l, WL_KV), 0, INF(12, l, 128), scr, r, 32, c.lane); continue; } r -= I_KV;
                transpose_item(INF(18, l, D * D), D, D, WPTR(l, WL_OUT), 0, nullptr, scr, r, 32, c.lane);
            }
            { const int* pos = (const int*)ap->in[1];
              for (int i = c.bid * 512 + c.tid; i < T * 16; i += c.G * 512) {
                  const int t = i >> 4, j = i & 15;
                  const float inv = exp2f(-(float)(2 * j) * (1.0f / 32.0f) * 13.287712379549449f);
                  const float ang = (float)pos[t] * inv;
                  const double rv = (double)ang * 0.15915494309189535; const float rr = (float)(rv - rint(rv));
                  cs[i] = __builtin_amdgcn_cosf(rr); sn[i] = __builtin_amdgcn_sinf(rr);
              } }
            resnorm_phase(c, nullptr, (const float*)ap->in[0], xb, nullptr, nullptr, 0.f, rrow);
            continue;
        }
        const int l = (ph - 1) / 12, sp = (ph - 1) % 12;
        if (sp == 0 || sp == 9) {
            pg8::Gemm g{xb, WPTR(l, sp == 0 ? WL_GU1 : WL_GU2), T, 2 * FF, D, D}; pg8::StaticOrder S; S.init(T, 2 * FF, c.G, c.bid);
            pg8::EpiSwiglu E{Rb, FF, rrow};
            for (int rep = 0; rep <= PROBE_GU; ++rep)
            pg8::gemm_phase<pg8::EpiSwiglu>(ldsl, g, S, E, wave_s);
        } else if (sp == 1 || sp == 10) {
            pg8::Gemm g{Rb, WPTR(l, sp == 1 ? WL_D1 : WL_D2), T, D, FF, FF}; pg8::StaticOrder S; S.init(T, D, c.G, c.bid);
            const bool fin = (l == 1 && sp == 10);
            pg8::EpiRes E{xb, fin ? ap->out : nullptr, sp == 1 ? INF(3, l, D) : INF(20, l, D), 0.5f, xch, (unsigned*)(ws + 65536) + (size_t)(l * 3 + (sp == 1 ? 0 : 2)) * 128 * 64, rrow};
            pg8::gemm_phase<pg8::EpiRes>(ldsl, g, S, E, wave_s);
        } else if (sp == 2) {
            FRESH_CTX();
            resnorm_phase(c, Fb, nullptr, xb, nullptr, INF(3, l, D), 0.5f, rrow);
        } else if (sp == 3) {
            pg8::Gemm g{xb, WPTR(l, WL_IN), T, DINP, D, D}; pg8::StaticOrder S; S.init(T, DINP, c.G, c.bid);
            pg8::EpiPlain E{proj, DINP, ssq, sskv, rrow};
            pg8::gemm_phase<pg8::EpiPlain>(ldsl, g, S, E, wave_s);
        } else if (sp == 4) {
            { pg8::Gemm g{proj + C_MQ, WPTR(l, WL_Q), T, 768, 256, DINP}; pg8::StaticOrder S; S.init(T, 768, c.G, c.bid);
              pg8::EpiQ E{Qb, ssq, cs, sn};
              for (int rep = 0; rep <= PROBE_SMALL; ++rep) pg8::gemm_phase<pg8::EpiQ>(ldsl, g, S, E, wave_s); }
            __syncthreads();
            { pg8::Gemm g{proj + C_MKV, WPTR(l, WL_KV), T, 1024, 128, DINP}; pg8::StaticOrder S; S.init(T, 1024, c.G, c.bid);
              pg8::EpiKV E{Kbuf, Vbuf, sskv, proj, cs, sn};
              for (int rep = 0; rep <= PROBE_SMALL; ++rep) { __syncthreads(); pg8::gemm_phase<pg8::EpiKV>(ldsl, g, S, E, wave_s); } }
            __syncthreads();
            float* wgl = (float*)(lds + WG_LDS_OFF);
            { const int t_ = fresh_tid(wave_s); const float* wsrc = INF(14, l, 16 * 128); const float* bsrc = INF(15, l, 128);
              for (int i = t_; i < 2048 + 128; i += NWAVES * 64) wgl[i] = (i < 2048) ? wsrc[i] : bsrc[i - 2048]; }
            __syncthreads();
            ChunkIn ci{proj, INF(14, l, 16 * 128), INF(15, l, 128), cs, sn};
            unsigned char* wl = lds + c.wave * 16384;
            for (int rep = 0; rep <= PROBE_CHUNK; ++rep)
            for (int u = gw; u < 4096; u += NGW) {
                const int lane2 = fresh_tid(wave_s) & 63;
                if (u < 2048) chunk_pass_a<true>(ci, wgl, u, wl, lane2, dS, dec);
                else chunk_pass_a<false>(ci, wgl, u - 2048, wl, lane2, dS + (size_t)2048 * 2048, dec + 2048 * 32);
            }
        } else if (sp == 5) {
            FRESH_CTX();
            for (int gi = c.bid * 512 + c.tid; gi < 131072; gi += c.G * 512) {
                const int e = gi & 63, d = (gi >> 6) & 31, h = (gi >> 11) & 3, b = (gi >> 13) & 7, ty = gi >> 16;
                float* base = dS + (size_t)ty * 2048 * 2048; const float* db = dec + (size_t)ty * 2048 * 32;
                float s = 0.f;
                for (int n0 = 0; n0 < 64; n0 += 16) {
                    float ds[16], dc[16];
#pragma unroll
                    for (int j = 0; j < 16; ++j) { const int unit = (b * 64 + n0 + j) * 4 + h; ds[j] = base[(size_t)unit * 2048 + d * 64 + e]; dc[j] = db[unit * 32 + d]; }
#pragma unroll
                    for (int j = 0; j < 16; ++j) { const int unit = (b * 64 + n0 + j) * 4 + h; base[(size_t)unit * 2048 + d * 64 + e] = s; s = dc[j] * s + ds[j]; }
                }
            }
            const int vcu = (c.G % 8 == 0) ? (c.bid % 8) * (c.G / 8) + c.bid / 8 : c.bid;
            for (int rep = 0; rep <= PROBE_ATTN; ++rep)
            for (int i = vcu; i < 1024; i += c.G) {
                const int j = i >> 8, ii = i & 255, bh = ii >> 2, s4 = ii & 3;
                const int qb = (j == 0) ? s4 : (j == 1) ? 7 - s4 : (j == 2) ? 8 + s4 : 15 - s4;
                attn_unit(c, bh, qb, Qb, Kbuf, Vbuf, omix);
            }
        } else if (sp == 6) {
            FRESH_CTX();
            float* wgl = (float*)(lds + WG_LDS_OFF);
            { const int t_ = fresh_tid(wave_s); const float* wsrc = INF(14, l, 16 * 128); const float* bsrc = INF(15, l, 128);
              for (int i = t_; i < 2048 + 128; i += NWAVES * 64) wgl[i] = (i < 2048) ? wsrc[i] : bsrc[i - 2048]; }
            __syncthreads();
            ChunkIn ci{proj, INF(14, l, 16 * 128), INF(15, l, 128), cs, sn};
            unsigned char* wl = lds + c.wave * 16384;
            for (int rep = 0; rep <= PROBE_CHUNK; ++rep)
            for (int u = gw; u < 4096; u += NGW) {
                const int lane2 = fresh_tid(wave_s) & 63;
                if (u < 2048) chunk_pass_c<true>(ci, wgl, u, wl, lane2, dS, INF(16, l, 64), omix);
                else chunk_pass_c<false>(ci, wgl, u - 2048, wl, lane2, dS + (size_t)2048 * 2048, INF(17, l, 64), omix);
            }
        } else if (sp == 7) {
            pg8::Gemm g{omix, WPTR(l, WL_OUT), T, D, D, D}; pg8::StaticOrder S; S.init(T, D, c.G, c.bid);
            pg8::EpiRes E{xb, nullptr, INF(8, l, D), 1.0f, xch, (unsigned*)(ws + 65536) + (size_t)(l * 3 + 1) * 128 * 64, rrow};
            pg8::gemm_phase<pg8::EpiRes>(ldsl, g, S, E, wave_s);
        } else if (sp == 8) {
            FRESH_CTX();
            resnorm_phase(c, Fb, nullptr, xb, nullptr, INF(8, l, D), 1.0f, rrow);
        } else {
            FRESH_CTX();
            resnorm_phase(c, Fb, nullptr, xb, (l == 1) ? ap->out : nullptr, INF(20, l, D), 0.5f, (l == 0) ? rrow : nullptr);
        }
    }
}

constexpr int N_PHASES = 25;

extern "C" void kernel_launch(void* const* d_in, const int* in_sizes, int n_in, void* d_out, int out_size, void* d_ws, size_t ws_size, hipStream_t stream) {
    static int grid = 0;
    if (grid == 0) {
        if (n_in != 24 || in_sizes[0] != T * D || out_size != T * D || ws_size < WS_END) { fprintf(stderr, "kernel_launch: unexpected shapes (n_in %d, in0 %d, out %d, ws %zu < %zu)\n", n_in, n_in > 0 ? in_sizes[0] : -1, out_size, ws_size, (size_t)WS_END); grid = -1; return; }
        int dev = 0, cus = 0, per_cu = 0;
        hipGetDevice(&dev); hipDeviceGetAttribute(&cus, hipDeviceAttributeMultiprocessorCount, dev);
        if (hipFuncSetAttribute((const void*)mega_fwd, hipFuncAttributeMaxDynamicSharedMemorySize, LDS_BYTES) != hipSuccess) { fprintf(stderr, "kernel_launch: hipFuncSetAttribute failed\n"); grid = -1; return; }
        if (hipOccupancyMaxActiveBlocksPerMultiprocessor(&per_cu, (const void*)mega_fwd, NWAVES * 64, LDS_BYTES) != hipSuccess || per_cu < 1) { fprintf(stderr, "kernel_launch: occupancy query says %d\n", per_cu); per_cu = 1; }
        (void)hipGetLastError();
        grid = cus * per_cu;
    }
    if (grid < 0) return;
    if (hipMemsetAsync((char*)d_ws + WS_CTL, 0, 1 << 20, stream) != hipSuccess) { fprintf(stderr, "kernel_launch: memset of the barrier words failed\n"); return; }
    Args a{};
    for (int i = 0; i < 24; ++i) a.in[i] = d_in[i];
    a.out = (float*)d_out; a.ws = (unsigned char*)d_ws;
#if MK_ONE_LAUNCH
    a.ph_lo = 0; a.ph_hi = N_PHASES;
    void* kargs[] = {&a};
    hipError_t e = hipLaunchCooperativeKernel((const void*)mega_fwd, dim3(grid), dim3(NWAVES * 64), kargs, LDS_BYTES, stream);
    if (e != hipSuccess) fprintf(stderr, "cooperative launch failed: %s (grid %d)\n", hipGetErrorString(e), grid);
#else
    for (int p = 0; p < N_PHASES; ++p) {
        a.ph_lo = p; a.ph_hi = p + 1;
        hipLaunchKernelGGL(mega_fwd, dim3(grid), dim3(NWAVES * 64), LDS_BYTES, stream, a);
    }
#endif
}
```

```cpp
#include <hip/hip_runtime.h>
#include <hip/hip_cooperative_groups.h>
#include <cstdio>
#include <cstdint>
namespace cg = cooperative_groups;

#ifndef PROBE_ATTN
#define PROBE_ATTN 0
#endif
#ifndef PROBE_GU
#define PROBE_GU 0
#endif
#ifndef PROBE_DOWN
#define PROBE_DOWN 0
#endif
#ifndef PROBE_CHUNK
#define PROBE_CHUNK 0
#endif
#ifndef PROBE_SMALL
#define PROBE_SMALL 0
#endif
#ifndef MK_ONE_LAUNCH
#define MK_ONE_LAUNCH 1
#endif

typedef unsigned short bf16_t;
typedef short bf16x8 __attribute__((ext_vector_type(8)));
typedef float f32x4 __attribute__((ext_vector_type(4)));
typedef float f32x16 __attribute__((ext_vector_type(16)));
typedef unsigned u32x4 __attribute__((ext_vector_type(4)));
typedef unsigned u32x2 __attribute__((ext_vector_type(2)));
typedef short v4i16_t __attribute__((ext_vector_type(4)));
#define LAS __attribute__((address_space(3)))
typedef float f32x2_t __attribute__((ext_vector_type(2)));
typedef __bf16 bf16x2_t __attribute__((ext_vector_type(2)));

__device__ __forceinline__ unsigned cvtpk(float lo, float hi) { f32x2_t v = {lo, hi}; bf16x2_t b = __builtin_convertvector(v, bf16x2_t); return __builtin_bit_cast(unsigned, b); }
__device__ __forceinline__ float bflo(unsigned w) { return __uint_as_float(w << 16); }
__device__ __forceinline__ float bfhi(unsigned w) { return __uint_as_float(w & 0xffff0000u); }
template <int X> __device__ __forceinline__ float swz_xor(float v) { return __int_as_float(__builtin_amdgcn_ds_swizzle(__float_as_int(v), (X << 10) | 0x1F)); }
__device__ __forceinline__ float wave_sum(float v) {
    v += swz_xor<1>(v); v += swz_xor<2>(v); v += swz_xor<4>(v); v += swz_xor<8>(v); v += swz_xor<16>(v);
    auto r = __builtin_amdgcn_permlane32_swap(__float_as_uint(v), __float_as_uint(v), false, false); return __uint_as_float(r[0]) + __uint_as_float(r[1]);
}

__device__ __forceinline__ float add_xor16(float v) { return v + __int_as_float(__builtin_amdgcn_ds_swizzle(__float_as_int(v), 0x401F)); }
__device__ __forceinline__ float add_xor32(float v) { auto r = __builtin_amdgcn_permlane32_swap(__float_as_uint(v), __float_as_uint(v), false, false); return __uint_as_float(r[0]) + __uint_as_float(r[1]); }

__device__ __forceinline__ int fresh_tid(int wave_s) { unsigned z = 0; asm volatile("" : "+v"(z)); return wave_s * 64 + (int)__builtin_amdgcn_mbcnt_hi(~0u, __builtin_amdgcn_mbcnt_lo(~0u, z)); }

constexpr int T = 32768, SEQ = 4096, D = 1024, FF = 2816, DINP = 2048, DIN = 1968;
constexpr int C_MQ = 0, C_MKV = 256, C_MKR = 384, C_GQ = 416, C_GK = 544, C_GV = 672, C_GG = 928, C_GR = 944, C_RQ = 1200, C_RK = 1328, C_RV = 1456, C_RG = 1712;
constexpr float EPS = 1e-6f;
constexpr float QSCALE = 0.10206207261596577f * 1.4426950408889634f;

namespace pg8 {
#define PG8_LAS __attribute__((address_space(3)))
constexpr int BM = 256, BK = 64, HALF = 128, HTB = HALF * BK * 2, STAGE_BYTES = 8 * HTB, NXCD = 8, WGM = 8;

__host__ __device__ __forceinline__ int lds_byte(int r, int c) { const int st = (r >> 4) * 2 + (c >> 5), rr = r & 15, cc = c & 31, ob = rr * 64 + cc * 2; return st * 1024 + (ob ^ (((ob >> 9) & 1) << 5)); }
__host__ __device__ __forceinline__ void stage_rc(int b, int& R, int& C) { const int st = b / 1024, sb = b % 1024, swz = sb ^ (((sb >> 9) & 1) << 5); R = (st >> 1) * 16 + swz / 64; C = (st & 1) * 32 + (swz % 64) / 2; }
__host__ __device__ __forceinline__ int perm32(int rho) { const int n = rho >> 4, i = rho & 15; return 8 * (i >> 2) + 4 * n + (i & 3); }

struct Unit { int pm, pn; };
struct Gemm { const bf16_t* A; const bf16_t* Bt; int M, N, K, lda; };

struct StaticOrder {
    int nM, nN, nwg, G, c;
    __host__ __device__ void init(int M, int N, int G_, int c_) { nM = M / BM; nN = N / BM; nwg = nM * nN; G = G_; c = c_; }
    __host__ __device__ bool next(int i, Unit& u) const {
        const long L = (long)i * G + c; if (L >= nwg) return false;
        int wgid = (int)L; { const int q = nwg / NXCD, r = nwg % NXCD, xcd = wgid % NXCD, off = wgid / NXCD; wgid = (xcd < r ? xcd * (q + 1) : r * (q + 1) + (xcd - r) * q) + off; }
        const int nig = WGM * nN, gid = wgid / nig, fm = gid * WGM, gsz = (nM - fm) < WGM ? (nM - fm) : WGM;
        u.pm = fm + ((wgid % nig) % gsz); u.pn = (wgid % nig) / gsz; return true;
    }
};


__device__ __forceinline__ float silu_f(float g) { return g * __builtin_amdgcn_rcpf(1.0f + __expf(-g)); }

struct EpiSwiglu {
    bf16_t* O; int ldc; const float* rr;
    __device__ __forceinline__ void prefetch(const Unit& u, int wr, int fr, float (&pre)[8]) const {
#pragma unroll
        for (int i = 0; i < 8; ++i) pre[i] = rr[u.pm * BM + wr * 64 + fr + (i >> 2) * HALF + (i & 3) * 16];
    }
    __device__ __forceinline__ void operator()(const f32x4 (&acc)[2][2][4][2], const Unit& u, int wr, int wc, int fr, int fq, const float (&pre)[8]) const {
        const int row0 = u.pm * BM + wr * 64 + fr; const int col0 = u.pn * 128 + wc * 32 + 8 * fq;
#pragma unroll
        for (int ai = 0; ai < 2; ++ai)
#pragma unroll
            for (int m = 0; m < 4; ++m) {
                bf16_t* rowp = O + (size_t)(row0 + ai * HALF + m * 16) * ldc + col0;
                const float rs = pre[ai * 4 + m];
                const f32x4 g0 = acc[ai][0][m][0] * rs, g1 = acc[ai][0][m][1] * rs, u0 = acc[ai][1][m][0] * rs, u1 = acc[ai][1][m][1] * rs;
                u32x4 w;
                w.x = cvtpk(silu_f(g0[0]) * u0[0], silu_f(g0[1]) * u0[1]); w.y = cvtpk(silu_f(g0[2]) * u0[2], silu_f(g0[3]) * u0[3]);
                w.z = cvtpk(silu_f(g1[0]) * u1[0], silu_f(g1[1]) * u1[1]); w.w = cvtpk(silu_f(g1[2]) * u1[2], silu_f(g1[3]) * u1[3]);
                *(u32x4*)rowp = w;
            }
    }
};

struct EpiPlain {
    bf16_t* O; int ldc; float* ssq; float* sskv; const float* rr;
    __device__ __forceinline__ void prefetch(const Unit& u, int wr, int fr, float (&pre)[8]) const {
#pragma unroll
        for (int i = 0; i < 8; ++i) pre[i] = rr ? rr[u.pm * BM + wr * 64 + fr + (i >> 2) * HALF + (i & 3) * 16] : 1.0f;
    }
    __device__ __forceinline__ void operator()(const f32x4 (&acc)[2][2][4][2], const Unit& u, int wr, int wc, int fr, int fq, const float (&pre)[8]) const {
        const int row0 = u.pm * BM + wr * 64 + fr; const int col0 = u.pn * BM + wc * 32 + 8 * fq;
        const bool do_q = (ssq != nullptr) && (u.pn == 0), do_kv = (ssq != nullptr) && (u.pn == 1);
#pragma unroll
        for (int ai = 0; ai < 2; ++ai)
#pragma unroll
            for (int m = 0; m < 4; ++m) {
                const int row = row0 + ai * HALF + m * 16;
                bf16_t* rowp = O + (size_t)row * ldc + col0;
                const float rs = pre[ai * 4 + m];
#pragma unroll
                for (int bj = 0; bj < 2; ++bj) {
                    const f32x4 v0 = acc[ai][bj][m][0] * rs, v1 = acc[ai][bj][m][1] * rs;
                    u32x4 w; w.x = cvtpk(v0[0], v0[1]); w.y = cvtpk(v0[2], v0[3]); w.z = cvtpk(v1[0], v1[1]); w.w = cvtpk(v1[2], v1[3]);
                    *(u32x4*)(rowp + bj * HALF) = w;
                    if (do_q || (do_kv && bj == 0)) {
                        float s = (v0[0] * v0[0] + v0[1] * v0[1]) + (v0[2] * v0[2] + v0[3] * v0[3]) + (v1[0] * v1[0] + v1[1] * v1[1]) + (v1[2] * v1[2] + v1[3] * v1[3]);
                        s = add_xor16(s); s = add_xor32(s);
                        if (fq == 0) { if (do_q) ssq[(size_t)row * 8 + bj * 4 + wc] = s; else sskv[(size_t)row * 4 + wc] = s; }
                    }
                }
            }
    }
};

struct EpiQ {
    bf16_t* Q; const float* ssq; const float* cs; const float* sn;
    __device__ __forceinline__ void prefetch(const Unit&, int, int, float (&pre)[8]) const {
#pragma unroll
        for (int i = 0; i < 8; ++i) pre[i] = 0.f; }
    __device__ __forceinline__ void operator()(const f32x4 (&acc)[2][2][4][2], const Unit& u, int wr, int wc, int fr, int fq, const float (&)[8]) const {
        const int row0 = u.pm * BM + wr * 64 + fr; const int col0 = u.pn * BM + wc * 32 + 8 * fq;
        const int dd = 8 * (fq & 1);
#pragma unroll
        for (int ai = 0; ai < 2; ++ai)
#pragma unroll
            for (int m = 0; m < 4; ++m) {
                const int row = row0 + ai * HALF + m * 16;
                const f32x4 s0 = *(const f32x4*)(ssq + (size_t)row * 8), s1 = *(const f32x4*)(ssq + (size_t)row * 8 + 4);
                const float tot = ((s0[0] + s0[1]) + (s0[2] + s0[3])) + ((s1[0] + s1[1]) + (s1[2] + s1[3]));
                const float sc = rsqrtf(tot * (1.0f / 256.0f) + EPS) * QSCALE;
                bf16_t* rowp = Q + (size_t)row * 768 + col0;
#pragma unroll
                for (int bj = 0; bj < 2; ++bj) {
                    f32x4 v0 = acc[ai][bj][m][0] * sc, v1 = acc[ai][bj][m][1] * sc;
                    const int G = 8 * u.pn + 4 * bj + wc;
                    if ((G % 3) == 2) {
                        const f32x4 c0 = *(const f32x4*)(cs + (size_t)row * 16 + dd), c1 = *(const f32x4*)(cs + (size_t)row * 16 + dd + 4);
                        const f32x4 n0 = *(const f32x4*)(sn + (size_t)row * 16 + dd), n1 = *(const f32x4*)(sn + (size_t)row * 16 + dd + 4);
                        f32x4 p0, p1;
#pragma unroll
                        for (int j = 0; j < 4; ++j) { const int pl = ((16 * fq + fr) ^ 32) * 4; p0[j] = __int_as_float(__builtin_amdgcn_ds_bpermute(pl, __float_as_int(v0[j]))); p1[j] = __int_as_float(__builtin_amdgcn_ds_bpermute(pl, __float_as_int(v1[j]))); }
                        if (fq < 2) { v0 = v0 * c0 - p0 * n0; v1 = v1 * c1 - p1 * n1; }
                        else        { v0 = p0 * n0 + v0 * c0; v1 = p1 * n1 + v1 * c1; }
                    }
                    u32x4 w; w.x = cvtpk(v0[0], v0[1]); w.y = cvtpk(v0[2], v0[3]); w.z = cvtpk(v1[0], v1[1]); w.w = cvtpk(v1[2], v1[3]);
                    *(u32x4*)(rowp + bj * HALF) = w;
                }
                if (m & 1) asm volatile("" ::: "memory");
            }
    }
};

struct EpiKV {
    bf16_t* Kb; bf16_t* Vb; const float* sskv; const bf16_t* proj; const float* cs; const float* sn;
    __device__ __forceinline__ void prefetch(const Unit&, int, int, float (&pre)[8]) const {
#pragma unroll
        for (int i = 0; i < 8; ++i) pre[i] = 0.f; }
    __device__ __forceinline__ void operator()(const f32x4 (&acc)[2][2][4][2], const Unit& u, int wr, int wc, int fr, int fq, const float (&)[8]) const {
        const int row0 = u.pm * BM + wr * 64 + fr;
#pragma unroll
        for (int ai = 0; ai < 2; ++ai)
#pragma unroll
            for (int m = 0; m < 4; ++m) {
                const int row = row0 + ai * HALF + m * 16;
                const f32x4 s0 = *(const f32x4*)(sskv + (size_t)row * 4);
                const float sc = rsqrtf(((s0[0] + s0[1]) + (s0[2] + s0[3])) * (1.0f / 128.0f) + EPS);
#pragma unroll
                for (int bj = 0; bj < 2; ++bj) {
                    const f32x4 v0 = acc[ai][bj][m][0] * sc, v1 = acc[ai][bj][m][1] * sc;
                    u32x4 w; w.x = cvtpk(v0[0], v0[1]); w.y = cvtpk(v0[2], v0[3]); w.z = cvtpk(v1[0], v1[1]); w.w = cvtpk(v1[2], v1[3]);
                    const int head = 2 * u.pn + bj;
                    if (wc < 2) *(u32x4*)(Kb + (size_t)row * 768 + head * 96 + wc * 32 + 8 * fq) = w;
                    else        *(u32x4*)(Vb + (size_t)row * 512 + head * 64 + (wc - 2) * 32 + 8 * fq) = w;
                }
                if (wc < 2) {
                    const u32x2 a = *(const u32x2*)(proj + (size_t)row * DINP + C_MKR + 4 * fq), b = *(const u32x2*)(proj + (size_t)row * DINP + C_MKR + 16 + 4 * fq);
                    const f32x4 c = *(const f32x4*)(cs + (size_t)row * 16 + 4 * fq), s = *(const f32x4*)(sn + (size_t)row * 16 + 4 * fq);
                    const f32x4 x1 = {bflo(a.x), bfhi(a.x), bflo(a.y), bfhi(a.y)}, x2 = {bflo(b.x), bfhi(b.x), bflo(b.y), bfhi(b.y)};
                    const f32x4 o = (wc == 0) ? (x1 * c - x2 * s) : (x1 * s + x2 * c);
                    u32x2 w; w.x = cvtpk(o[0], o[1]); w.y = cvtpk(o[2], o[3]);
#pragma unroll
                    for (int bj = 0; bj < 2; ++bj) *(u32x2*)(Kb + (size_t)row * 768 + (2 * u.pn + bj) * 96 + 64 + wc * 16 + 4 * fq) = w;
                }
                if (m & 1) asm volatile("" ::: "memory");
            }
    }
};

struct EpiRes {
    bf16_t* xb; float* xf32; const float* post_g; float scale; float* xch; unsigned* cnt; float* rr;
    __device__ __forceinline__ void prefetch(const Unit&, int, int, float (&pre)[8]) const {
#pragma unroll
        for (int i = 0; i < 8; ++i) pre[i] = 0.f; }
    __device__ __forceinline__ void operator()(const f32x4 (&acc)[2][2][4][2], const Unit& u, int wr, int wc, int fr, int fq, const float (&)[8]) const {
        int zl_ = 0; asm volatile("" : "+v"(zl_));
        LAS float* P = (LAS float*)(132096 + zl_);
        LAS float* S = P + 1024;
        float* xnp = xch + 4 * 65536;
        const int wid = wr * 4 + wc, lane = fq * 16 + fr, tid = wid * 64 + lane;
#define ER_BAR() do { asm volatile("s_waitcnt lgkmcnt(0)" ::: "memory"); __builtin_amdgcn_s_barrier(); asm volatile("" ::: "memory"); } while (0)
        const int col0 = u.pn * BM + wc * 32 + 8 * fq;
        u32x4 xw[2][4][2]; f32x4 gg[2][2];
#pragma unroll
        for (int ai = 0; ai < 2; ++ai)
#pragma unroll
            for (int m = 0; m < 4; ++m)
#pragma unroll
                for (int bj = 0; bj < 2; ++bj) xw[ai][m][bj] = *(const u32x4*)(xb + (size_t)(u.pm * BM + ai * HALF + wr * 64 + m * 16 + fr) * 1024 + col0 + bj * HALF);
#pragma unroll
        for (int bj = 0; bj < 2; ++bj) { gg[bj][0] = *(const f32x4*)(post_g + col0 + bj * HALF); gg[bj][1] = *(const f32x4*)(post_g + col0 + bj * HALF + 4); }
#pragma unroll
        for (int ai = 0; ai < 2; ++ai)
#pragma unroll
            for (int m = 0; m < 4; ++m) {
                float sq = 0.f;
#pragma unroll
                for (int bj = 0; bj < 2; ++bj)
#pragma unroll
                    for (int n = 0; n < 2; ++n) { const f32x4 v = acc[ai][bj][m][n]; sq += (v[0] * v[0] + v[1] * v[1]) + (v[2] * v[2] + v[3] * v[3]); }
                sq = add_xor16(sq); sq = add_xor32(sq);
                if (fq == 0) P[(ai * HALF + wr * 64 + m * 16 + fr) * 4 + wc] = sq;
            }
        ER_BAR();
        if (tid < 256) { const float tot = (P[tid * 4] + P[tid * 4 + 1]) + (P[tid * 4 + 2] + P[tid * 4 + 3]);
            __hip_atomic_store((unsigned*)xch + ((size_t)(u.pm * BM + tid) * 4 + u.pn), __float_as_uint(tot), __ATOMIC_RELAXED, __HIP_MEMORY_SCOPE_AGENT); }
        asm volatile("s_waitcnt vmcnt(0)" ::: "memory");
        if (lane == 0) __hip_atomic_fetch_add(cnt + 64 * u.pm, 1u, __ATOMIC_RELAXED, __HIP_MEMORY_SCOPE_AGENT);
        if (wid == 0) {
            unsigned spins = 0;
            while ((unsigned)__builtin_amdgcn_readfirstlane(__hip_atomic_load(cnt + 64 * u.pm, __ATOMIC_RELAXED, __HIP_MEMORY_SCOPE_AGENT)) < 32u) { __builtin_amdgcn_s_sleep(2); if (++spins > (1u << 22)) break; }
            __builtin_amdgcn_fence(__ATOMIC_ACQUIRE, "agent");
        }
        asm volatile("s_waitcnt vmcnt(0)" ::: "memory");
        ER_BAR();
        if (tid < 256) { const unsigned* xs = (const unsigned*)xch + (size_t)(u.pm * BM + tid) * 4; float tot = 0.f;
#pragma unroll
            for (int t = 0; t < 4; ++t) tot += __uint_as_float(__hip_atomic_load(xs + t, __ATOMIC_RELAXED, __HIP_MEMORY_SCOPE_AGENT));
            S[tid] = rsqrtf(tot * (1.0f / 1024.0f) + EPS) * scale; }
        ER_BAR();
#pragma unroll
        for (int ai = 0; ai < 2; ++ai)
#pragma unroll
            for (int m = 0; m < 4; ++m) {
                const int rl = ai * HALF + wr * 64 + m * 16 + fr; const size_t row = (size_t)(u.pm * BM + rl);
                const float rf = S[rl]; float s2 = 0.f;
#pragma unroll
                for (int bj = 0; bj < 2; ++bj) {
                    const u32x4 xq = xw[ai][m][bj];
                    const f32x4 x0 = {bflo(xq.x), bfhi(xq.x), bflo(xq.y), bfhi(xq.y)}, x1 = {bflo(xq.z), bfhi(xq.z), bflo(xq.w), bfhi(xq.w)};
                    const f32x4 v0 = x0 + acc[ai][bj][m][0] * rf * gg[bj][0], v1 = x1 + acc[ai][bj][m][1] * rf * gg[bj][1];
                    s2 += ((v0[0] * v0[0] + v0[1] * v0[1]) + (v0[2] * v0[2] + v0[3] * v0[3])) + ((v1[0] * v1[0] + v1[1] * v1[1]) + (v1[2] * v1[2] + v1[3] * v1[3]));
                    if (xf32) { *(f32x4*)(xf32 + row * 1024 + col0 + bj * HALF) = v0; *(f32x4*)(xf32 + row * 1024 + col0 + bj * HALF + 4) = v1; }
                    else { u32x4 w; w.x = cvtpk(v0[0], v0[1]); w.y = cvtpk(v0[2], v0[3]); w.z = cvtpk(v1[0], v1[1]); w.w = cvtpk(v1[2], v1[3]); *(u32x4*)(xb + row * 1024 + col0 + bj * HALF) = w; }
                }
                s2 = add_xor16(s2); s2 = add_xor32(s2);
                if (fq == 0) P[rl * 4 + wc] = s2;
            }
        ER_BAR();
        if (!xf32) {
            if (tid < 256) __hip_atomic_store((unsigned*)xnp + ((size_t)(u.pm * BM + tid) * 4 + u.pn), __float_as_uint((P[tid * 4] + P[tid * 4 + 1]) + (P[tid * 4 + 2] + P[tid * 4 + 3])), __ATOMIC_RELAXED, __HIP_MEMORY_SCOPE_AGENT);
            asm volatile("s_waitcnt vmcnt(0)" ::: "memory");
            ER_BAR();
            if (tid == 0) { const unsigned old = __hip_atomic_fetch_add(cnt + 6 * 128 * 64 + 64 * u.pm, 1u, __ATOMIC_RELAXED, __HIP_MEMORY_SCOPE_AGENT); __builtin_amdgcn_fence(__ATOMIC_ACQUIRE, "agent"); S[0] = (old == 3u) ? 1.0f : 0.0f; }
            asm volatile("s_waitcnt vmcnt(0)" ::: "memory");
            ER_BAR();
            if (S[0] != 0.0f && tid < 256) { const unsigned* xs = (const unsigned*)xnp + (size_t)(u.pm * BM + tid) * 4; float tot = 0.f;
#pragma unroll
                for (int t = 0; t < 4; ++t) tot += __uint_as_float(__hip_atomic_load(xs + t, __ATOMIC_RELAXED, __HIP_MEMORY_SCOPE_AGENT));
                rr[u.pm * BM + tid] = rsqrtf(tot * (1.0f / 1024.0f) + EPS); }
        }
#undef ER_BAR
    }
};

template <class Epi>
__device__ __forceinline__ void gemm_phase(PG8_LAS unsigned char* lds, const Gemm g, const StaticOrder& S, const Epi& E, const int wave_s) {
    const int tid = fresh_tid(wave_s);
    const int wid = __builtin_amdgcn_readfirstlane(tid >> 6), lane = tid & 63, wr = wid >> 2, wc = wid & 3, fr = lane & 15, fq = lane >> 4;
    int K_ = g.K, lda_ = g.lda; asm volatile("" : "+s"(K_), "+s"(lda_));
    const int K = K_, nt = K / BK, lda = lda_;
    unsigned voffA[2], voffB[2];
#pragma unroll
    for (int i = 0; i < 2; ++i) { int R, C; stage_rc(tid * 16 + i * 8192, R, C); const int Rb = (R & ~31) + perm32(R & 31);
        voffA[i] = (unsigned)(R * lda + C) * 2u; voffB[i] = (unsigned)(Rb * K + C) * 2u; }
    const size_t kstep = (size_t)(BK * 2);
    const size_t hstepA = (size_t)HALF * lda * 2, hstepB = (size_t)HALF * K * 2;
    const size_t tstepA = 2 * hstepA, tstepB = 2 * hstepB;
    const unsigned ldsw = (unsigned)wid * 1024u;
    const int aoff = lds_byte(wr * 64 + fr, fq * 8), boff = lds_byte(wc * 32 + fr, fq * 8);
#define PG8_SA(b, h) (((b) * 2 + (h)) * HTB)
#define PG8_SB(b, h) ((4 + (b) * 2 + (h)) * HTB)
#define PG8_STAGE(bufoff, gbase, voff) do { _Pragma("unroll") for (int _i = 0; _i < 2; ++_i) \
        __builtin_amdgcn_global_load_lds((const unsigned*)((const char*)(gbase) + (voff)[_i]), (PG8_LAS unsigned*)(lds + (bufoff) + ldsw + _i * 8192), 16, 0, 0); } while (0)
#define PG8_LDA(dst, b, h) do { _Pragma("unroll") for (int m = 0; m < 4; ++m) _Pragma("unroll") for (int k = 0; k < 2; ++k) dst[m][k] = *(const PG8_LAS bf16x8*)(lds + PG8_SA(b, h) + aoff + m * 2048 + k * 1024); } while (0)
#define PG8_LDB(dst, b, h) do { _Pragma("unroll") for (int n = 0; n < 2; ++n) _Pragma("unroll") for (int k = 0; k < 2; ++k) dst[n][k] = *(const PG8_LAS bf16x8*)(lds + PG8_SB(b, h) + boff + n * 2048 + k * 1024); } while (0)
#define PG8_MMA(ai, bj, At, Bt) do { __builtin_amdgcn_s_setprio(1); _Pragma("unroll") for (int m = 0; m < 4; ++m) _Pragma("unroll") for (int n = 0; n < 2; ++n) _Pragma("unroll") for (int k = 0; k < 2; ++k) \
        acc[ai][bj][m][n] = __builtin_amdgcn_mfma_f32_16x16x32_bf16(Bt[n][k], At[m][k], acc[ai][bj][m][n], 0, 0, 0); __builtin_amdgcn_s_setprio(0); } while (0)
#define PG8_WAIT_V(n) asm volatile("s_waitcnt vmcnt(" #n ")" ::: "memory")
#define PG8_WAIT_L(n) asm volatile("s_waitcnt lgkmcnt(" #n ")" ::: "memory")
#define PG8_BAR __builtin_amdgcn_s_barrier()
#define PG8_SCHED __builtin_amdgcn_sched_barrier(0)
    Unit cur, nxt; int ui = 0;
    if (!S.next(0, cur)) return;
    f32x4 acc[2][2][4][2];
#pragma unroll
    for (int a = 0; a < 2; ++a)
#pragma unroll
        for (int b = 0; b < 2; ++b)
#pragma unroll
            for (int m = 0; m < 4; ++m)
#pragma unroll
                for (int n = 0; n < 2; ++n) acc[a][b][m][n] = (f32x4){0.f, 0.f, 0.f, 0.f};
    bf16x8 At[4][2], B0[2][2], B1[2][2];
    const char* cA = (const char*)g.A + (size_t)cur.pm * tstepA; const char* cB = (const char*)g.Bt + (size_t)cur.pn * tstepB;
    PG8_STAGE(PG8_SB(0, 0), cB, voffB); PG8_STAGE(PG8_SB(0, 1), cB + hstepB, voffB); PG8_STAGE(PG8_SA(0, 0), cA, voffA); PG8_STAGE(PG8_SA(0, 1), cA + hstepA, voffA);
    if (wr == 1) PG8_BAR;
    PG8_WAIT_V(2); PG8_BAR;
    PG8_STAGE(PG8_SB(1, 0), cB + kstep, voffB); PG8_STAGE(PG8_SA(1, 0), cA + kstep, voffA); PG8_STAGE(PG8_SB(1, 1), cB + hstepB + kstep, voffB);
    PG8_WAIT_V(6); PG8_BAR;
    for (;;) {
        const bool has_next = S.next(ui + 1, nxt);
        const char* nA = has_next ? (const char*)g.A + (size_t)nxt.pm * tstepA : cA; const char* nB = has_next ? (const char*)g.Bt + (size_t)nxt.pn * tstepB : cB;
        float pre[8]; E.prefetch(cur, wr, fr, pre);
        for (int t = 0; t < nt; t += 2) {
            const bool last = (t == nt - 2);
            const char* a1 = cA + (size_t)(t + 1) * kstep;
            const char* a2 = last ? nA : cA + (size_t)(t + 2) * kstep; const char* b2 = last ? nB : cB + (size_t)(t + 2) * kstep;
            const char* a3 = a2 + kstep; const char* b3 = b2 + kstep;
            PG8_LDB(B0, 0, 0); PG8_LDB(B1, 0, 1); PG8_SCHED; PG8_LDA(At, 0, 0); PG8_STAGE(PG8_SA(1, 1), a1 + hstepA, voffA);
            PG8_WAIT_V(8); PG8_WAIT_L(0); PG8_BAR; PG8_MMA(0, 0, At, B0); PG8_MMA(0, 1, At, B1); PG8_BAR; PG8_SCHED;
            PG8_LDA(At, 0, 1); PG8_STAGE(PG8_SB(0, 0), b2, voffB); PG8_STAGE(PG8_SB(0, 1), b2 + hstepB, voffB); PG8_STAGE(PG8_SA(0, 0), a2, voffA);
            PG8_WAIT_V(8); PG8_WAIT_L(0); PG8_BAR; PG8_MMA(1, 0, At, B0); PG8_MMA(1, 1, At, B1); PG8_BAR; PG8_SCHED;
            PG8_LDB(B0, 1, 0); PG8_LDB(B1, 1, 1); PG8_SCHED; PG8_LDA(At, 1, 0); PG8_STAGE(PG8_SA(0, 1), a2 + hstepA, voffA);
            PG8_WAIT_V(8); PG8_WAIT_L(0); PG8_BAR; PG8_MMA(0, 0, At, B0); PG8_MMA(0, 1, At, B1); PG8_BAR; PG8_SCHED;
            PG8_LDA(At, 1, 1); PG8_STAGE(PG8_SB(1, 0), b3, voffB); PG8_STAGE(PG8_SB(1, 1), b3 + hstepB, voffB); PG8_STAGE(PG8_SA(1, 0), a3, voffA);
            PG8_WAIT_V(8); PG8_WAIT_L(0); PG8_BAR; PG8_MMA(1, 0, At, B0); PG8_MMA(1, 1, At, B1); PG8_BAR; PG8_SCHED;
        }
        if (wr == 0) PG8_BAR;
        { const int tl = fresh_tid(wave_s); const int w2 = wave_s, l2 = tl & 63;
          E(acc, cur, w2 >> 2, w2 & 3, l2 & 15, l2 >> 4, pre); }
        if (!has_next) break;
#pragma unroll
        for (int a = 0; a < 2; ++a)
#pragma unroll
            for (int b = 0; b < 2; ++b)
#pragma unroll
                for (int m = 0; m < 4; ++m)
#pragma unroll
                    for (int n = 0; n < 2; ++n) acc[a][b][m][n] = (f32x4){0.f, 0.f, 0.f, 0.f};
        cur = nxt; cA = nA; cB = nB; ++ui;
        if (wr == 1) PG8_BAR;
    }
    PG8_WAIT_V(0);
    PG8_BAR;
#undef PG8_SA
#undef PG8_SB
#undef PG8_STAGE
#undef PG8_LDA
#undef PG8_LDB
#undef PG8_MMA
#undef PG8_WAIT_V
#undef PG8_WAIT_L
#undef PG8_BAR
#undef PG8_SCHED
}
}

constexpr size_t MiB = 1u << 20;
constexpr size_t WS_W = 1 * MiB;
constexpr size_t WL_GU1 = 0, WL_D1 = 11 * MiB, WL_GU2 = 17 * MiB, WL_D2 = 28 * MiB, WL_IN = 34 * MiB, WL_OUT = 38 * MiB, WL_Q = 40 * MiB, WL_KV = 40 * MiB + 512 * 1024, WL_STRIDE = 41 * MiB;
constexpr size_t WS_H = 83 * MiB;
constexpr size_t WS_F = 147 * MiB;
constexpr size_t WS_R = 211 * MiB;
constexpr size_t WS_Q = WS_R + 128 * MiB;
constexpr size_t WS_XB = 387 * MiB;
constexpr size_t WS_DS = 451 * MiB;
constexpr size_t WS_DEC = 483 * MiB;
constexpr size_t WS_CS = 484 * MiB;
constexpr size_t WS_SN = 486 * MiB;
constexpr size_t WS_SSQ = 488 * MiB;
constexpr size_t WS_SSKV = 489 * MiB;
constexpr size_t WS_RR = 489 * MiB + 512 * 1024;
constexpr size_t WS_END = 490 * MiB;
static_assert(WL_OUT + 2 * MiB <= WL_Q && WL_IN + 4 * MiB <= WL_OUT && WL_D2 + 6 * MiB <= WL_IN, "weight map");

constexpr int LDS_BYTES = 147456;
constexpr int BAR_LDS_OFF = 131072 + 256;
constexpr int WG_LDS_OFF = 131072 + 1024;
constexpr size_t WS_CTL = 0;
constexpr int NWAVES = 8;

struct Args { const void* in[24]; float* out; unsigned char* ws; int ph_lo, ph_hi; };

struct Ctx { unsigned char* lds; int tid, lane, wave, G, bid; };

__device__ __forceinline__ void transpose_item(const float* W, int K, int N, bf16_t* WT, int mode, const float* kscale, float* scr, int item, int nblk, int lane) {
    const int kb = item / nblk, nb = item % nblk, k0 = 64 * kb, n0 = 32 * nb;
    const int nn = n0 + (lane & 31);
    float wv[32];
#pragma unroll
    for (int i = 0; i < 32; ++i) { const int kk = 2 * i + (lane >> 5); wv[i] = (nn < N) ? W[(size_t)(k0 + kk) * N + nn] : 0.f; }
#pragma unroll
    for (int i = 0; i < 32; ++i) { const int kk = 2 * i + (lane >> 5); float v = wv[i]; if (kscale) v *= kscale[k0 + kk]; scr[kk * 33 + (lane & 31)] = v; }
    __builtin_amdgcn_s_waitcnt(0); asm volatile("" ::: "memory");
    const int c = lane & 7;
    int drow0 = n0; if (mode == 1) drow0 = (n0 / 128) * 256 + (n0 % 128); else if (mode == 2) drow0 = (n0 / 128) * 256 + 128 + (n0 % 128);
#pragma unroll
    for (int j = 0; j < 4; ++j) { const int n = (lane >> 3) + 8 * j; const float* s = scr + (8 * c) * 33 + n;
        u32x4 o; o.x = cvtpk(s[0 * 33], s[1 * 33]); o.y = cvtpk(s[2 * 33], s[3 * 33]); o.z = cvtpk(s[4 * 33], s[5 * 33]); o.w = cvtpk(s[6 * 33], s[7 * 33]);
        *(u32x4*)(WT + (size_t)(drow0 + n) * K + k0 + 8 * c) = o; }
    __builtin_amdgcn_s_waitcnt(0); asm volatile("" ::: "memory");
}

__device__ __forceinline__ void resnorm_phase(const Ctx& c, const bf16_t* F, const float* xin32, bf16_t* xb, float* xf32, const float* post_g, float scale, float* rr) {
    constexpr int RN = 4;
    const int gw = c.bid * NWAVES + c.wave, NGW = c.G * NWAVES;
    for (int row0 = gw * RN; row0 < T; row0 += NGW * RN) {
        f32x4 xv[RN][4]; u32x2 fw[RN][4];
#pragma unroll
        for (int q = 0; q < RN; ++q)
#pragma unroll
            for (int j = 0; j < 4; ++j) {
                const size_t off = (size_t)(row0 + q) * D + j * 256 + c.lane * 4;
                if (xin32) xv[q][j] = *(const f32x4*)(xin32 + off);
                else { const u32x2 w = *(const u32x2*)(xb + off); xv[q][j] = (f32x4){bflo(w.x), bfhi(w.x), bflo(w.y), bfhi(w.y)}; }
                if (F) fw[q][j] = *(const u32x2*)(F + off);
            }
#pragma unroll
        for (int q = 0; q < RN; ++q) {
            const int row = row0 + q;
            if (F) {
                f32x4 fv[4]; float ss = 0.f;
#pragma unroll
                for (int j = 0; j < 4; ++j) { const u32x2 w = fw[q][j]; fv[j] = (f32x4){bflo(w.x), bfhi(w.x), bflo(w.y), bfhi(w.y)};
                    ss += (fv[j][0] * fv[j][0] + fv[j][1] * fv[j][1]) + (fv[j][2] * fv[j][2] + fv[j][3] * fv[j][3]); }
                const float r = rsqrtf(wave_sum(ss) * (1.0f / D) + EPS) * scale;
#pragma unroll
                for (int j = 0; j < 4; ++j) { const f32x4 g = *(const f32x4*)(post_g + j * 256 + c.lane * 4); xv[q][j] = xv[q][j] + fv[j] * r * g; }
            }
            if (xf32) {
#pragma unroll
                for (int j = 0; j < 4; ++j) *(f32x4*)(xf32 + (size_t)row * D + j * 256 + c.lane * 4) = xv[q][j];
            } else {
#pragma unroll
                for (int j = 0; j < 4; ++j) { const f32x4 o = xv[q][j]; u32x2 w; w.x = cvtpk(o[0], o[1]); w.y = cvtpk(o[2], o[3]); *(u32x2*)(xb + (size_t)row * D + j * 256 + c.lane * 4) = w; }
            }
            if (rr) {
                float ss = 0.f;
#pragma unroll
                for (int j = 0; j < 4; ++j) ss += (xv[q][j][0] * xv[q][j][0] + xv[q][j][1] * xv[q][j][1]) + (xv[q][j][2] * xv[q][j][2] + xv[q][j][3] * xv[q][j][3]);
                const float r = rsqrtf(wave_sum(ss) * (1.0f / D) + EPS);
                if (c.lane == 0) rr[row] = r;
            }
        }
    }
}

constexpr int AT_K = 0, AT_V = 12288, AT_VP = 192, AT_BUF = 12288 + 64 * AT_VP  , AT_WS = 3 * AT_BUF;
__device__ __forceinline__ int crow(int r, int hi) { return (r & 3) + 8 * (r >> 2) + 4 * hi; }
__device__ __forceinline__ float max3f(float a, float b, float c) { float r; asm("v_max3_f32 %0, %1, %2, %3" : "=v"(r) : "v"(a), "v"(b), "v"(c)); return r; }

__device__ __forceinline__ void attn_unit(const Ctx& c, int bh, int qb, const bf16_t* Q, const bf16_t* Kb, const bf16_t* Vb, bf16_t* O) {
    const int tid = c.tid, lane = c.lane, wid = c.wave, r32 = lane & 31, hi = lane >> 5;
    const int b = bh >> 3, h = bh & 7;
    const size_t rowbase = (size_t)b * SEQ;
    const int q0 = qb * 256;
    unsigned char* lds = c.lds;
    const LAS unsigned char* ldsa = (const LAS unsigned char*)c.lds;
    float* wsf = (float*)(lds + AT_WS) + wid * 64;
    bf16x8 qr[6];
    { const bf16_t* qp = Q + (rowbase + q0 + wid * 32 + r32) * 768 + h * 96 + hi * 8;
#pragma unroll
      for (int d0 = 0; d0 < 6; ++d0) qr[d0] = *(const bf16x8*)(qp + d0 * 16); }
    const int NT = 4 * qb + 4, ntw = 4 * qb + (wid >> 1) + 1;
    const int kr0 = tid / 12, kc0 = tid % 12, kr1 = (512 + tid) / 12, kc1 = (512 + tid) % 12;
    const bf16_t* kg0 = Kb + (rowbase + kr0) * 768 + h * 96 + kc0 * 8;
    const bf16_t* kg1 = Kb + (rowbase + kr1) * 768 + h * 96 + kc1 * 8;
    const bf16_t* vg = Vb + (rowbase + (tid >> 3)) * 512 + h * 64 + (tid & 7) * 8;
    const int ks0 = AT_K + kc0 * 1024 + ((kr0 & 48) | ((kr0 ^ kc0) & 15)) * 16, ks1 = AT_K + kc1 * 1024 + ((kr1 & 48) | ((kr1 ^ kc1) & 15)) * 16;
    const int vs0 = AT_V + (tid >> 3) * AT_VP + (tid & 7) * 16;
    const int kx = r32 ^ hi;
    const int vtb = AT_V + (4 * hi + ((lane & 15) >> 2)) * AT_VP + (16 * ((lane >> 4) & 1) + 4 * (lane & 3)) * 2;
    u32x4 k0rA, k1rA, vrA, k0rB, k1rB, vrB;
#define AT_LOAD(t_, S) do { const int tc_ = (t_) < NT ? (t_) : NT - 1; const size_t off_ = (size_t)tc_ * 64; k0r##S = *(const u32x4*)(kg0 + off_ * 768); k1r##S = *(const u32x4*)(kg1 + off_ * 768); vr##S = *(const u32x4*)(vg + off_ * 512); } while (0)
#define AT_STORE(bo_, S) do { unsigned char* lb_ = lds + (bo_); *(u32x4*)(lb_ + ks0) = k0r##S; if (tid < 256) *(u32x4*)(lb_ + ks1) = k1r##S; *(u32x4*)(lb_ + vs0) = vr##S; } while (0)
#define AT_QK(P0, P1, bo_) do { const unsigned char* kb_ = lds + (bo_) + AT_K + hi * 1024 + (r32 & 16) * 16; \
        _Pragma("unroll") for (int d0 = 0; d0 < 6; ++d0) { const unsigned char* kd_ = kb_ + d0 * 2048 + ((kx ^ (2 * d0)) & 15) * 16; const bf16x8 a0_ = *(const bf16x8*)(kd_), a1_ = *(const bf16x8*)(kd_ + 512); \
            if (d0 == 0) { P0 = __builtin_amdgcn_mfma_f32_32x32x16_bf16(a0_, qr[0], f32x16{}, 0, 0, 0); P1 = __builtin_amdgcn_mfma_f32_32x32x16_bf16(a1_, qr[0], f32x16{}, 0, 0, 0); } \
            else { P0 = __builtin_amdgcn_mfma_f32_32x32x16_bf16(a0_, qr[d0], P0, 0, 0, 0); P1 = __builtin_amdgcn_mfma_f32_32x32x16_bf16(a1_, qr[d0], P1, 0, 0, 0); } } } while (0)
#define AT_MAX(C0, C1, tt_) do { \
        asm volatile("s_nop 15\n\ts_nop 2" : "+v"(C0), "+v"(C1));     \
        float ma_ = max3f(C0[0], C0[1], C1[0]), mb_ = max3f(C0[2], C0[3], C1[1]); ma_ = max3f(ma_, C1[2], C1[3]); \
        _Pragma("unroll") for (int r = 4; r < 16; r += 4) { ma_ = max3f(ma_, C0[r], C0[r + 1]); mb_ = max3f(mb_, C0[r + 2], C0[r + 3]); ma_ = max3f(ma_, C1[r], C1[r + 1]); mb_ = max3f(mb_, C1[r + 2], C1[r + 3]); } \
        float mx_ = max3f(ma_, mb_, mb_); \
        { auto sw_ = __builtin_amdgcn_permlane32_swap(__float_as_uint(mx_), __float_as_uint(mx_), false, false); mx_ = max3f(__uint_as_float(sw_[0]), __uint_as_float(sw_[1]), mx_); }     \
        const bool upd_ = ((tt_) == 0) || (mx_ > mrow + 8.0f); \
        if (__any(upd_)) { \
            const float mn_ = upd_ ? mx_ : mrow; \
            const float alpha_ = __builtin_amdgcn_exp2f(mrow - mn_); mrow = mn_; lsum *= alpha_; \
            if (hi == 0) wsf[r32] = alpha_; \
            asm volatile("" ::: "memory"); \
            _Pragma("unroll") for (int r = 0; r < 16; ++r) { const float a_ = wsf[crow(r, hi)]; o[0][r] *= a_; o[1][r] *= a_; } \
            asm volatile("" ::: "memory"); \
        } } while (0)
#define SB_() __builtin_amdgcn_sched_barrier(0)
#define KFR_(d0_, A0, A1) do { const unsigned char* kd_ = kbn_ + (d0_) * 2048 + ((kx ^ (2 * (d0_))) & 15) * 16; A0 = *(const bf16x8*)(kd_); A1 = *(const bf16x8*)(kd_ + 512); } while (0)
#define VFR_(g_, VV) do { const LAS unsigned char* vb_ = ldsa + b0 + vtb + ((g_) & 1) * 64 + ((g_) >> 1) * 16 * AT_VP; \
        const u32x2 lo_ = __builtin_bit_cast(u32x2, __builtin_amdgcn_ds_read_tr16_b64_v4i16((LAS v4i16_t*)(vb_))), hh_ = __builtin_bit_cast(u32x2, __builtin_amdgcn_ds_read_tr16_b64_v4i16((LAS v4i16_t*)(vb_ + 8 * AT_VP))); \
        VV = (u32x4){lo_.x, lo_.y, hh_.x, hh_.y}; } while (0)
#define EX_(P, r) P[r] = __builtin_amdgcn_exp2f(P[r] - mrow)
#define AT_FAST(C0, C1, N0, N1) do { \
        const unsigned char* kbn_ = lds + b1 + AT_K + hi * 1024 + (r32 & 16) * 16; \
        bf16x8 ka0_, ka1_, kb0_, kb1_; u32x4 pw0_, pw1_, pw2_, pw3_, va_, vb2_; float ps_ = 0.f; \
        KFR_(0, ka0_, ka1_); SB_(); \
          \
        KFR_(1, kb0_, kb1_); N0 = __builtin_amdgcn_mfma_f32_32x32x16_bf16(ka0_, qr[0], f32x16{}, 0, 0, 0); EX_(C0, 0); EX_(C0, 1); SB_(); \
        N1 = __builtin_amdgcn_mfma_f32_32x32x16_bf16(ka1_, qr[0], f32x16{}, 0, 0, 0); EX_(C0, 2); EX_(C0, 3); SB_(); \
        KFR_(2, ka0_, ka1_); N0 = __builtin_amdgcn_mfma_f32_32x32x16_bf16(kb0_, qr[1], N0, 0, 0, 0); EX_(C0, 4); EX_(C0, 5); SB_(); \
        N1 = __builtin_amdgcn_mfma_f32_32x32x16_bf16(kb1_, qr[1], N1, 0, 0, 0); EX_(C0, 6); EX_(C0, 7); SB_(); \
        KFR_(3, kb0_, kb1_); N0 = __builtin_amdgcn_mfma_f32_32x32x16_bf16(ka0_, qr[2], N0, 0, 0, 0); EX_(C0, 8); EX_(C0, 9); SB_(); \
        N1 = __builtin_amdgcn_mfma_f32_32x32x16_bf16(ka1_, qr[2], N1, 0, 0, 0); EX_(C0, 10); EX_(C0, 11); SB_(); \
        KFR_(4, ka0_, ka1_); N0 = __builtin_amdgcn_mfma_f32_32x32x16_bf16(kb0_, qr[3], N0, 0, 0, 0); EX_(C0, 12); EX_(C0, 13); SB_(); \
        N1 = __builtin_amdgcn_mfma_f32_32x32x16_bf16(kb1_, qr[3], N1, 0, 0, 0); EX_(C0, 14); EX_(C0, 15); SB_(); \
        KFR_(5, kb0_, kb1_); N0 = __builtin_amdgcn_mfma_f32_32x32x16_bf16(ka0_, qr[4], N0, 0, 0, 0); ps_ += (C0[0] + C0[1]) + (C0[2] + C0[3]); pw0_.x = cvtpk(C0[0], C0[1]); pw0_.y = cvtpk(C0[2], C0[3]); SB_(); \
        N1 = __builtin_amdgcn_mfma_f32_32x32x16_bf16(ka1_, qr[4], N1, 0, 0, 0); ps_ += (C0[4] + C0[5]) + (C0[6] + C0[7]); pw0_.z = cvtpk(C0[4], C0[5]); pw0_.w = cvtpk(C0[6], C0[7]); SB_(); \
        VFR_(0, va_); N0 = __builtin_amdgcn_mfma_f32_32x32x16_bf16(kb0_, qr[5], N0, 0, 0, 0); ps_ += (C0[8] + C0[9]) + (C0[10] + C0[11]); pw1_.x = cvtpk(C0[8], C0[9]); pw1_.y = cvtpk(C0[10], C0[11]); SB_(); \
        VFR_(1, vb2_); N1 = __builtin_amdgcn_mfma_f32_32x32x16_bf16(kb1_, qr[5], N1, 0, 0, 0); ps_ += (C0[12] + C0[13]) + (C0[14] + C0[15]); pw1_.z = cvtpk(C0[12], C0[13]); pw1_.w = cvtpk(C0[14], C0[15]); SB_(); \
          \
        o[0] = __builtin_amdgcn_mfma_f32_32x32x16_bf16(__builtin_bit_cast(bf16x8, pw0_), __builtin_bit_cast(bf16x8, va_), o[0], 0, 0, 0); VFR_(2, va_); EX_(C1, 0); EX_(C1, 1); EX_(C1, 2); EX_(C1, 3); SB_(); \
        o[1] = __builtin_amdgcn_mfma_f32_32x32x16_bf16(__builtin_bit_cast(bf16x8, pw0_), __builtin_bit_cast(bf16x8, vb2_), o[1], 0, 0, 0); VFR_(3, vb2_); EX_(C1, 4); EX_(C1, 5); EX_(C1, 6); EX_(C1, 7); SB_(); \
        o[0] = __builtin_amdgcn_mfma_f32_32x32x16_bf16(__builtin_bit_cast(bf16x8, pw1_), __builtin_bit_cast(bf16x8, va_), o[0], 0, 0, 0); VFR_(4, va_); EX_(C1, 8); EX_(C1, 9); EX_(C1, 10); EX_(C1, 11); pw2_.x = cvtpk(C1[0], C1[1]); pw2_.y = cvtpk(C1[2], C1[3]); SB_(); \
        o[1] = __builtin_amdgcn_mfma_f32_32x32x16_bf16(__builtin_bit_cast(bf16x8, pw1_), __builtin_bit_cast(bf16x8, vb2_), o[1], 0, 0, 0); VFR_(5, vb2_); EX_(C1, 12); EX_(C1, 13); EX_(C1, 14); EX_(C1, 15); pw2_.z = cvtpk(C1[4], C1[5]); pw2_.w = cvtpk(C1[6], C1[7]); SB_(); \
        o[0] = __builtin_amdgcn_mfma_f32_32x32x16_bf16(__builtin_bit_cast(bf16x8, pw2_), __builtin_bit_cast(bf16x8, va_), o[0], 0, 0, 0); VFR_(6, va_); ps_ += (C1[0] + C1[1]) + (C1[2] + C1[3]); pw3_.x = cvtpk(C1[8], C1[9]); pw3_.y = cvtpk(C1[10], C1[11]); SB_(); \
        o[1] = __builtin_amdgcn_mfma_f32_32x32x16_bf16(__builtin_bit_cast(bf16x8, pw2_), __builtin_bit_cast(bf16x8, vb2_), o[1], 0, 0, 0); VFR_(7, vb2_); ps_ += (C1[4] + C1[5]) + (C1[6] + C1[7]); pw3_.z = cvtpk(C1[12], C1[13]); pw3_.w = cvtpk(C1[14], C1[15]); SB_(); \
        o[0] = __builtin_amdgcn_mfma_f32_32x32x16_bf16(__builtin_bit_cast(bf16x8, pw3_), __builtin_bit_cast(bf16x8, va_), o[0], 0, 0, 0); ps_ += (C1[8] + C1[9]) + (C1[10] + C1[11]); SB_(); \
        o[1] = __builtin_amdgcn_mfma_f32_32x32x16_bf16(__builtin_bit_cast(bf16x8, pw3_), __builtin_bit_cast(bf16x8, vb2_), o[1], 0, 0, 0); ps_ += (C1[12] + C1[13]) + (C1[14] + C1[15]); SB_(); \
        lsum += ps_; } while (0)
#define AT_STEP(C0, C1, N0, N1, t_, S) do { const int tt_ = (t_); \
        AT_STORE(b2, S);                        \
        AT_LOAD(tt_ + 4, S); \
        if (tt_ < ntw) {          \
            AT_MAX(C0, C1, tt_); \
            AT_FAST(C0, C1, N0, N1); \
        } \
        asm volatile("s_waitcnt lgkmcnt(0)" ::: "memory"); __builtin_amdgcn_s_barrier(); asm volatile("" ::: "memory");     \
        { const int tb_ = b0; b0 = b1; b1 = b2; b2 = tb_; } } while (0)

    int b0 = 0, b1 = AT_BUF, b2 = 2 * AT_BUF;
    float mrow = -1e30f, lsum = 0.f;
    f32x16 o[2]; o[0] = f32x16{}; o[1] = f32x16{};
    AT_LOAD(0, A); AT_LOAD(1, B); AT_STORE(b0, A); AT_LOAD(2, A); AT_STORE(b1, B); AT_LOAD(3, B);
    __syncthreads();
    f32x16 pA0, pA1, pB0, pB1;
    AT_QK(pA0, pA1, b0);
    for (int t = 0; t < NT; t += 2) {
        AT_STEP(pA0, pA1, pB0, pB1, t, A);
        AT_STEP(pB0, pB1, pA0, pA1, t + 1, B);
    }
#undef AT_LOAD
#undef AT_STORE
#undef AT_QK
#undef AT_FAST
#undef SB_
#undef KFR_
#undef VFR_
#undef EX_
#undef AT_MAX
#undef AT_STEP
    { auto sw_ = __builtin_amdgcn_permlane32_swap(__float_as_uint(lsum), __float_as_uint(lsum), false, false); lsum = __uint_as_float(sw_[0]) + __uint_as_float(sw_[1]); }
    if (hi == 0) wsf[r32] = 1.0f / lsum;
    asm volatile("" ::: "memory");
    bf16_t* op = O + (rowbase + q0 + wid * 32) * 1024 + h * 64 + r32;
#pragma unroll
    for (int r = 0; r < 16; ++r) { const int qq = crow(r, hi); const float rl = wsf[qq];
        op[(size_t)qq * 1024] = (bf16_t)(cvtpk(o[0][r] * rl, 0.f) & 0xffffu); op[(size_t)qq * 1024 + 32] = (bf16_t)(cvtpk(o[1][r] * rl, 0.f) & 0xffffu); }
    asm volatile("" ::: "memory");
}

constexpr int GP = 144;
struct ChunkIn { const bf16_t* proj; const float* wgu; const float* bg; const float* cs; const float* sn; };

struct ChunkRaw { u32x2 qa, qb, ka, kb; u32x4 g0, g1; f32x4 cc, ss; };
template <bool GLA>
__device__ __forceinline__ void chunk_load(const ChunkIn& ci, int t, int h, int kq, ChunkRaw& r) {
    const bf16_t* pr = ci.proj + (size_t)t * DINP;
    const int cq = GLA ? C_GQ : C_RQ, ck = GLA ? C_GK : C_RK;
    r.qa = *(const u32x2*)(pr + cq + h * 32 + 4 * kq); r.qb = *(const u32x2*)(pr + cq + h * 32 + 16 + 4 * kq);
    r.ka = *(const u32x2*)(pr + ck + h * 32 + 4 * kq); r.kb = *(const u32x2*)(pr + ck + h * 32 + 16 + 4 * kq);
    if (GLA) { r.g0 = *(const u32x4*)(pr + C_GG); r.g1 = *(const u32x4*)(pr + C_GG + 8); }
    else { r.cc = *(const f32x4*)(ci.cs + (size_t)t * 16 + 4 * kq); r.ss = *(const f32x4*)(ci.sn + (size_t)t * 16 + 4 * kq); }
}
template <bool GLA>
__device__ __forceinline__ void chunk_tile(const ChunkRaw& raw, const bf16x8 (&wfr)[2], const f32x4 (&bfr)[2], int h, int it, int row, int kq, float lg, float (&carry)[8], float (&bq)[8], float (&qv)[8], float (&kv)[8]) {
    const u32x2 qa = raw.qa, qb = raw.qb, ka = raw.ka, kb = raw.kb;
    float q[8] = {bflo(qa.x), bfhi(qa.x), bflo(qa.y), bfhi(qa.y), bflo(qb.x), bfhi(qb.x), bflo(qb.y), bfhi(qb.y)};
    float k[8] = {bflo(ka.x), bfhi(ka.x), bflo(ka.y), bfhi(ka.y), bflo(kb.x), bfhi(kb.x), bflo(kb.y), bfhi(kb.y)};
    const float qs = 0.17677669529663687f;
    if (GLA) {
        const u32x4 gsel = (kq == 0) ? raw.g0 : (kq == 1) ? raw.g1 : (u32x4){0u, 0u, 0u, 0u};
        const bf16x8 gfr = __builtin_bit_cast(bf16x8, gsel);
        const f32x4 z0 = __builtin_amdgcn_mfma_f32_16x16x32_bf16(wfr[0], gfr, bfr[0], 0, 0, 0), z1 = __builtin_amdgcn_mfma_f32_16x16x32_bf16(wfr[1], gfr, bfr[1], 0, 0, 0);
        const float z[8] = {z0[0], z0[1], z0[2], z0[3], z1[0], z1[1], z1[2], z1[3]};
#pragma unroll
        for (int j = 0; j < 8; ++j) {
            float la = (fminf(z[j], 0.f) - __logf(1.0f + __expf(-fabsf(z[j])))) * (1.0f / 16.0f);
            la += __int_as_float(__builtin_amdgcn_update_dpp(0, __float_as_int(la), 0x111, 0xf, 0xf, false));
            la += __int_as_float(__builtin_amdgcn_update_dpp(0, __float_as_int(la), 0x112, 0xf, 0xf, false));
            la += __int_as_float(__builtin_amdgcn_update_dpp(0, __float_as_int(la), 0x114, 0xf, 0xf, false));
            la += __int_as_float(__builtin_amdgcn_update_dpp(0, __float_as_int(la), 0x118, 0xf, 0xf, false));
            bq[j] = la + carry[j];
            carry[j] += __int_as_float(__builtin_amdgcn_ds_bpermute((16 * kq + 15) * 4, __float_as_int(la)));
            qv[j] = q[j] * qs; kv[j] = k[j];
        }
    } else {
        const f32x4 cc = raw.cc, ss = raw.ss;
#pragma unroll
        for (int j = 0; j < 4; ++j) {
            qv[j] = (q[j] * cc[j] - q[4 + j] * ss[j]) * qs; qv[4 + j] = (q[j] * ss[j] + q[4 + j] * cc[j]) * qs;
            kv[j] = k[j] * cc[j] - k[4 + j] * ss[j];        kv[4 + j] = k[j] * ss[j] + k[4 + j] * cc[j];
        }
#pragma unroll
        for (int j = 0; j < 8; ++j) { bq[j] = (float)(16 * it + row + 1) * lg; carry[j] = 64.0f * lg; }
    }
}

__device__ __forceinline__ void chunk_gate_frags(const float* wgl, int h, int row, int kq, bf16x8 (&wfr)[2], f32x4 (&bfr)[2]) {
#pragma unroll
    for (int nt = 0; nt < 2; ++nt) {
        float w[8];
#pragma unroll
        for (int j = 0; j < 8; ++j) w[j] = (kq < 2) ? wgl[(8 * (kq & 1) + j) * 128 + h * 32 + 16 * nt + row] : 0.f;
        wfr[nt] = __builtin_bit_cast(bf16x8, (u32x4){cvtpk(w[0], w[1]), cvtpk(w[2], w[3]), cvtpk(w[4], w[5]), cvtpk(w[6], w[7])});
        bfr[nt] = *(const f32x4*)(wgl + 2048 + h * 32 + 16 * nt + 4 * kq);
    }
}

__device__ __forceinline__ void chunk_load_vt(const bf16_t* proj, int t0, int vcol, unsigned char* wl, int lane) {
    const bf16_t* vp = proj + (size_t)(t0 + lane) * DINP + vcol;
#pragma unroll
    for (int cidx = 0; cidx < 8; ++cidx) {
        const u32x4 v = *(const u32x4*)(vp + cidx * 8);
        const unsigned w4[4] = {v.x, v.y, v.z, v.w};
#pragma unroll
        for (int j = 0; j < 4; ++j) {
            *(bf16_t*)(wl + (cidx * 8 + 2 * j) * GP + lane * 2) = (bf16_t)(w4[j] & 0xffffu);
            *(bf16_t*)(wl + (cidx * 8 + 2 * j + 1) * GP + lane * 2) = (bf16_t)(w4[j] >> 16);
        }
    }
}

template <bool GLA>
__device__ __forceinline__ void chunk_pass_a(const ChunkIn& ci, const float* wgl, int unit, unsigned char* wl, int lane, float* dS, float* dec) {
    const int h = unit & 3, bn = unit >> 2, t0 = bn * 64;
    const int row = lane & 15, kq = lane >> 4;
    float carry[8] = {0.f, 0.f, 0.f, 0.f, 0.f, 0.f, 0.f, 0.f};
    float bq[4][8], kk[4][8];
    int hh_ = h; asm volatile("" : "+s"(hh_)); const float hf = (float)hh_;
    const float lg = GLA ? 0.f : __logf(1.0f - __builtin_amdgcn_exp2f(-5.0f - hf));
    ChunkRaw raw[4];
#pragma unroll
    for (int it = 0; it < 4; ++it) chunk_load<GLA>(ci, t0 + 16 * it + row, h, kq, raw[it]);
    bf16x8 wfr[2]; f32x4 bfr[2]; if (GLA) chunk_gate_frags(wgl, h, row, kq, wfr, bfr);
#pragma unroll
    for (int it = 0; it < 4; ++it) { float qv[8]; chunk_tile<GLA>(raw[it], wfr, bfr, h, it, row, kq, lg, carry, bq[it], qv, kk[it]); }
    unsigned char* kst = wl + 64 * GP;
#pragma unroll
    for (int it = 0; it < 4; ++it)
#pragma unroll
        for (int j = 0; j < 8; ++j) {
            const int d = (j < 4) ? (4 * kq + j) : (16 + 4 * kq + (j - 4));
            const float ks = kk[it][j] * __expf(carry[j] - bq[it][j]);
            *(bf16_t*)(kst + d * GP + (16 * it + row) * 2) = (bf16_t)(cvtpk(ks, 0.f) & 0xffffu);
        }
    chunk_load_vt(ci.proj, t0, (GLA ? C_GV : C_RV) + h * 64, wl, lane);
    __builtin_amdgcn_s_waitcnt(0); asm volatile("" ::: "memory");
    float* out = dS + (size_t)unit * 2048;
#pragma unroll
    for (int dt = 0; dt < 2; ++dt)
#pragma unroll
        for (int et = 0; et < 4; ++et) {
            f32x4 acc = {0.f, 0.f, 0.f, 0.f};
#pragma unroll
            for (int ks = 0; ks < 2; ++ks) {
                const bf16x8 a = *(const bf16x8*)(kst + (16 * dt + row) * GP + (32 * ks + 8 * kq) * 2);
                const bf16x8 bb = *(const bf16x8*)(wl + (16 * et + row) * GP + (32 * ks + 8 * kq) * 2);
                acc = __builtin_amdgcn_mfma_f32_16x16x32_bf16(a, bb, acc, 0, 0, 0);
            }
#pragma unroll
            for (int r = 0; r < 4; ++r) out[(16 * dt + 4 * kq + r) * 64 + 16 * et + row] = acc[r];
        }
    if (row == 0) {
#pragma unroll
        for (int j = 0; j < 8; ++j) { const int d = (j < 4) ? (4 * kq + j) : (16 + 4 * kq + (j - 4)); dec[(size_t)unit * 32 + d] = __expf(carry[j]); }
    }
    __builtin_amdgcn_s_waitcnt(0); asm volatile("" ::: "memory");
}

template <bool GLA>
__device__ __forceinline__ void chunk_pass_c(const ChunkIn& ci, const float* wgl, int unit, unsigned char* wl, int lane, const float* Sb, const float* ng, bf16_t* omix) {
    const int h = unit & 3, bn = unit >> 2, t0 = bn * 64;
    const int row = lane & 15, kq = lane >> 4;
    chunk_load_vt(ci.proj, t0, (GLA ? C_GV : C_RV) + h * 64, wl, lane);
    unsigned char* sst = wl + 64 * GP;
    { const float* sp = Sb + (size_t)unit * 2048 + lane;
      float sv[32];
#pragma unroll
      for (int d = 0; d < 32; ++d) sv[d] = sp[d * 64];
#pragma unroll
      for (int q4 = 0; q4 < 4; ++q4) {
          u32x4 w; w.x = cvtpk(sv[4 * q4 + 0], sv[4 * q4 + 1]); w.y = cvtpk(sv[4 * q4 + 2], sv[4 * q4 + 3]); w.z = cvtpk(sv[16 + 4 * q4 + 0], sv[16 + 4 * q4 + 1]); w.w = cvtpk(sv[16 + 4 * q4 + 2], sv[16 + 4 * q4 + 3]);
          *(u32x4*)(sst + lane * 64 + q4 * 16) = w;
      } }
    asm volatile("" ::: "memory");
    float carry[8] = {0.f, 0.f, 0.f, 0.f, 0.f, 0.f, 0.f, 0.f};
    int hh_ = h; asm volatile("" : "+s"(hh_)); const float hf = (float)hh_;
    const float lg = GLA ? 0.f : __logf(1.0f - __builtin_amdgcn_exp2f(-5.0f - hf));
    bf16x8 qf[4], kf[4], qb[4], kb[4];
    ChunkRaw raw[4];
#pragma unroll
    for (int it = 0; it < 4; ++it) chunk_load<GLA>(ci, t0 + 16 * it + row, h, kq, raw[it]);
    bf16x8 wfr[2]; f32x4 bfr[2]; if (GLA) chunk_gate_frags(wgl, h, row, kq, wfr, bfr);
#pragma unroll
    for (int it = 0; it < 4; ++it) {
        float bq[8], qv[8], kv[8];
        chunk_tile<GLA>(raw[it], wfr, bfr, h, it, row, kq, lg, carry, bq, qv, kv);
        float a[8], bneg[8], cpos[8], dneg[8];
#pragma unroll
        for (int j = 0; j < 8; ++j) { const float eb = __expf(bq[j]), enb = __expf(-bq[j]); a[j] = qv[j] * eb; bneg[j] = kv[j] * enb; cpos[j] = qv[j] * enb; dneg[j] = kv[j] * eb; }
        qf[it] = __builtin_bit_cast(bf16x8, (u32x4){cvtpk(a[0], a[1]), cvtpk(a[2], a[3]), cvtpk(a[4], a[5]), cvtpk(a[6], a[7])});
        kf[it] = __builtin_bit_cast(bf16x8, (u32x4){cvtpk(bneg[0], bneg[1]), cvtpk(bneg[2], bneg[3]), cvtpk(bneg[4], bneg[5]), cvtpk(bneg[6], bneg[7])});
        qb[it] = __builtin_bit_cast(bf16x8, (u32x4){cvtpk(cpos[0], cpos[1]), cvtpk(cpos[2], cpos[3]), cvtpk(cpos[4], cpos[5]), cvtpk(cpos[6], cpos[7])});
        kb[it] = __builtin_bit_cast(bf16x8, (u32x4){cvtpk(dneg[0], dneg[1]), cvtpk(dneg[2], dneg[3]), cvtpk(dneg[4], dneg[5]), cvtpk(dneg[6], dneg[7])});
        asm volatile("" ::: "memory");
    }
    __builtin_amdgcn_s_waitcnt(0); asm volatile("" ::: "memory");
    bf16x8 vfr[4][2], sfr[4];
#pragma unroll
    for (int et = 0; et < 4; ++et) {
#pragma unroll
        for (int p = 0; p < 2; ++p) {
            const u32x2 lo = *(const u32x2*)(wl + (16 * et + row) * GP + (32 * p + 4 * kq) * 2), hh = *(const u32x2*)(wl + (16 * et + row) * GP + (32 * p + 16 + 4 * kq) * 2);
            vfr[et][p] = __builtin_bit_cast(bf16x8, (u32x4){lo.x, lo.y, hh.x, hh.y});
        }
        sfr[et] = *(const bf16x8*)(sst + (16 * et + row) * 64 + kq * 16);
    }
    const int gcol = (GLA ? C_GR : C_RG) + h * 64, ocol = (GLA ? 512 : 768) + h * 64;
    float gn[4];
#pragma unroll
    for (int et = 0; et < 4; ++et) gn[et] = ng[16 * et + row];
#pragma unroll
    for (int it = 0; it < 4; ++it) {
        f32x4 st[4];
#pragma unroll
        for (int jt = 0; jt < 4; ++jt) {
            const f32x4 z = {0.f, 0.f, 0.f, 0.f};
            if (jt < it) st[jt] = __builtin_amdgcn_mfma_f32_16x16x32_bf16(kf[jt], qf[it], z, 0, 0, 0);
            else if (jt > it) st[jt] = __builtin_amdgcn_mfma_f32_16x16x32_bf16(kb[jt], qb[it], z, 0, 0, 0);
            else {
                const f32x4 lo = __builtin_amdgcn_mfma_f32_16x16x32_bf16(kf[jt], qf[it], z, 0, 0, 0), up = __builtin_amdgcn_mfma_f32_16x16x32_bf16(kb[jt], qb[it], z, 0, 0, 0);
#pragma unroll
                for (int r = 0; r < 4; ++r) st[jt][r] = (4 * kq + r <= row) ? lo[r] : up[r];
            }
        }
        bf16x8 af[2];
#pragma unroll
        for (int p = 0; p < 2; ++p)
            af[p] = __builtin_bit_cast(bf16x8, (u32x4){cvtpk(st[2 * p][0], st[2 * p][1]), cvtpk(st[2 * p][2], st[2 * p][3]), cvtpk(st[2 * p + 1][0], st[2 * p + 1][1]), cvtpk(st[2 * p + 1][2], st[2 * p + 1][3])});
        f32x4 o[4]; float ss[4] = {0.f, 0.f, 0.f, 0.f};
#pragma unroll
        for (int et = 0; et < 4; ++et) {
            f32x4 acc = {0.f, 0.f, 0.f, 0.f};
            acc = __builtin_amdgcn_mfma_f32_16x16x32_bf16(af[0], vfr[et][0], acc, 0, 0, 0);
            acc = __builtin_amdgcn_mfma_f32_16x16x32_bf16(af[1], vfr[et][1], acc, 0, 0, 0);
            acc = __builtin_amdgcn_mfma_f32_16x16x32_bf16(qf[it], sfr[et], acc, 0, 0, 0);
            o[et] = acc;
#pragma unroll
            for (int r = 0; r < 4; ++r) ss[r] += acc[r] * acc[r];
        }
#pragma unroll
        for (int r = 0; r < 4; ++r) {
            ss[r] += swz_xor<1>(ss[r]); ss[r] += swz_xor<2>(ss[r]); ss[r] += swz_xor<4>(ss[r]); ss[r] += swz_xor<8>(ss[r]);
            const float rs = rsqrtf(ss[r] * (1.0f / 64.0f) + EPS);
            const int t = t0 + 16 * it + 4 * kq + r;
#pragma unroll
            for (int et = 0; et < 4; ++et) {
                const int e = 16 * et + row;
                const float gt = __uint_as_float((unsigned)ci.proj[(size_t)t * DINP + gcol + e] << 16);
                const float val = o[et][r] * rs * gn[et] * pg8::silu_f(gt);
                omix[(size_t)t * 1024 + ocol + e] = (bf16_t)(cvtpk(val, 0.f) & 0xffffu);
            }
        }
    }
    __builtin_amdgcn_s_waitcnt(0); asm volatile("" ::: "memory");
}

#define XB_TMO      128
#define XB_XCNT(j)  (256  + 64 * (j))
#define XB_XSUB(j)  (1280 + 64 * (j))
#define XB_XGEN(j)  (2304 + 64 * (j))
#define XB_TOP      3328
#define XB_TOPGEN   3392
#define XCD_BAR_WORDS 3456
#define XB_SPIN_CAP (1u << 18)

__device__ __forceinline__ unsigned xb_ld(unsigned* p)              { return __hip_atomic_load(p, __ATOMIC_RELAXED, __HIP_MEMORY_SCOPE_AGENT); }
__device__ __forceinline__ unsigned xb_add(unsigned* p, unsigned v) { return __hip_atomic_fetch_add(p, v, __ATOMIC_RELAXED, __HIP_MEMORY_SCOPE_AGENT); }
__device__ __forceinline__ unsigned xb_xcc_id() { return (unsigned)__builtin_amdgcn_s_getreg((3 << 11) | 20) & 0xFu; }
#define XB_SPIN(cond, bar) do { unsigned _sp = 0; while (cond) { __builtin_amdgcn_s_sleep(1); \
    if ((++_sp & 255u) == 0u) { if (xb_ld(&(bar)[XB_TMO])) break; if (_sp > XB_SPIN_CAP) { atomicAdd(&(bar)[XB_TMO], 1u); break; } } } } while (0)

struct XcdBarrier {
    unsigned* bar; unsigned x;
    volatile LAS unsigned* st;
};

__device__ __forceinline__ XcdBarrier xcd_barrier_post(unsigned* bar, volatile LAS unsigned* st) {
    XcdBarrier b; b.bar = bar; b.x = xb_xcc_id(); b.st = st;
    if (threadIdx.x == 0) (void)xb_add(&bar[XB_XCNT(b.x)], 1u);
    return b;
}
__device__ __forceinline__ void xcd_barrier_complete(unsigned* bar, unsigned x, unsigned& nloc, unsigned& nx) {
    const unsigned G = gridDim.x * gridDim.y * gridDim.z;
    unsigned sum, cnt, mine, sp = 0u;
    for (;;) {
        sum = 0u; cnt = 0u; mine = 0u;
#pragma unroll
        for (unsigned j = 0; j < 16; ++j) { const unsigned c = xb_ld(&bar[XB_XCNT(j)]); sum += c; cnt += (c > 0u) ? 1u : 0u; mine = (j == x) ? c : mine; }
        if (sum == G) break;
        __builtin_amdgcn_s_sleep(1);
        if ((++sp & 255u) == 0u) { if (xb_ld(&bar[XB_TMO])) break; if (sp > XB_SPIN_CAP) { atomicAdd(&bar[XB_TMO], 1u); break; } }
    }
    nloc = mine > 0u ? mine : 1u; nx = cnt > 0u ? cnt : 1u;
}

__device__ __forceinline__ void xcd_barrier(const XcdBarrier& b) {
    asm volatile("s_waitcnt vmcnt(0)" ::: "memory");
    __syncthreads();
    if (threadIdx.x == 0) {
        unsigned* bar = b.bar;
        __builtin_amdgcn_s_waitcnt(0);
        unsigned nloc = b.st[0], nx = b.st[1];
        if (nloc == 0u) { xcd_barrier_complete(bar, b.x, nloc, nx); b.st[0] = nloc; b.st[1] = nx; }
        const unsigned old = xb_add(&bar[XB_XSUB(b.x)], 1u);
        const unsigned gen = old / nloc;
        if (old + 1u == (gen + 1u) * nloc) {
            __builtin_amdgcn_fence(__ATOMIC_RELEASE, "agent");
            asm volatile("s_waitcnt vmcnt(0)" ::: "memory");
            const unsigned og = xb_add(&bar[XB_TOP], 1u);
            const unsigned tg = og / nx;
            if (og + 1u == (tg + 1u) * nx) xb_add(&bar[XB_TOPGEN], 1u);
            else XB_SPIN(xb_ld(&bar[XB_TOPGEN]) == tg, bar);
            __builtin_amdgcn_fence(__ATOMIC_ACQUIRE, "agent");
            xb_add(&bar[XB_XGEN(b.x)], 1u);
            asm volatile("s_waitcnt vmcnt(0)" ::: "memory");
        } else {
            XB_SPIN(xb_ld(&bar[XB_XGEN(b.x)]) == gen, bar);
            __builtin_amdgcn_fence(__ATOMIC_ACQUIRE, "agent");
            asm volatile("s_waitcnt vmcnt(0)" ::: "memory");
        }
    }
    __syncthreads();
}


__global__ void __launch_bounds__(NWAVES * 64, 2) mega_fwd(Args args) {
    extern __shared__ __attribute__((aligned(16))) unsigned char lds[];
    const int lo = args.ph_lo, hi = args.ph_hi;
    const int wave_s = __builtin_amdgcn_readfirstlane((int)threadIdx.x >> 6);
    volatile LAS unsigned* bst = (volatile LAS unsigned*)((LAS unsigned char*)lds + BAR_LDS_OFF);
    if (threadIdx.x < 4) bst[threadIdx.x] = 0u;
    __syncthreads();
    XcdBarrier xbar = xcd_barrier_post((unsigned*)(args.ws + WS_CTL) + 64, bst);
#define WPTR(l, off) ((bf16_t*)(ws + WS_W + (size_t)(l) * WL_STRIDE + (off)))
#define INF(i, l, n) ((const float*)ap->in[i] + (size_t)(l) * (n))

    for (int ph = lo; ph < hi; ++ph) {
        { const int sp_ = (ph > 0) ? (ph - 1) % 12 : -1; if (sp_ == 2 || sp_ == 8 || sp_ == 11 || sp_ == 6) continue; }
        if (ph > lo) { if (hi > (1 << 20)) cg::this_grid().sync(); else xcd_barrier(xbar); }
        const __attribute__((address_space(4))) Args* ap = (const __attribute__((address_space(4))) Args*)__builtin_amdgcn_kernarg_segment_ptr(); asm volatile("" : "+s"(ap));
        Ctx c; c.lds = lds; c.tid = 0; c.lane = 0; c.wave = wave_s; { int g_ = gridDim.x, b_ = blockIdx.x; asm volatile("" : "+s"(g_), "+s"(b_)); c.G = g_; c.bid = b_; }
#define FRESH_CTX() do { c.tid = fresh_tid(wave_s); c.lane = c.tid & 63; } while (0)
        unsigned char* ws = ap->ws;
        bf16_t* xb = (bf16_t*)(ws + WS_XB); float* rrow = (float*)(ws + WS_RR);
        float* xch = (float*)(ws + WS_F + 48 * MiB);
        bf16_t* Hb = (bf16_t*)(ws + WS_H); bf16_t* Fb = (bf16_t*)(ws + WS_F); bf16_t* Rb = (bf16_t*)(ws + WS_R); bf16_t* Qb = (bf16_t*)(ws + WS_Q);
        bf16_t* Kbuf = Hb; bf16_t* Vbuf = Fb; bf16_t* proj = Rb; bf16_t* omix = (bf16_t*)ap->out;
        float* dS = (float*)(ws + WS_DS); float* dec = (float*)(ws + WS_DEC); float* cs = (float*)(ws + WS_CS); float* sn = (float*)(ws + WS_SN);
        float* ssq = (float*)(ws + WS_SSQ); float* sskv = (float*)(ws + WS_SSKV);
        const int gw = c.bid * NWAVES + c.wave, NGW = c.G * NWAVES;
        PG8_LAS unsigned char* ldsl = (PG8_LAS unsigned char*)lds;
        if (ph == 0) {
            FRESH_CTX();
            float* scr = (float*)(lds + c.wave * 16384);
            constexpr int I_G = 16 * 88, I_D = 44 * 32, I_IN = 16 * 64, I_Q = 4 * 24, I_KV = 2 * 32, I_O = 16 * 32;
            constexpr int PER_L = 6 * I_G + I_IN + I_Q + I_KV + I_O;
            static_assert(I_G == I_D, "items");
            for (int it = gw; it < 2 * PER_L; it += NGW) {
                const int l = it / PER_L; int r = it % PER_L;
                if (r < I_G) { transpose_item(INF(4, l, D * FF), D, FF, WPTR(l, WL_GU1), 1, INF(2, l, D), scr, r, 88, c.lane); continue; } r -= I_G;
                if (r < I_G) { transpose_item(INF(5, l, D * FF), D, FF, WPTR(l, WL_GU1), 2, INF(2, l, D), scr, r, 88, c.lane); continue; } r -= I_G;
                if (r < I_D) { transpose_item(INF(6, l, D * FF), FF, D, WPTR(l, WL_D1), 0, nullptr, scr, r, 32, c.lane); continue; } r -= I_D;
                if (r < I_G) { transpose_item(INF(21, l, D * FF), D, FF, WPTR(l, WL_GU2), 1, INF(19, l, D), scr, r, 88, c.lane); continue; } r -= I_G;
                if (r < I_G) { transpose_item(INF(22, l, D * FF), D, FF, WPTR(l, WL_GU2), 2, INF(19, l, D), scr, r, 88, c.lane); continue; } r -= I_G;
                if (r < I_D) { transpose_item(INF(23, l, D * FF), FF, D, WPTR(l, WL_D2), 0, nullptr, scr, r, 32, c.lane); continue; } r -= I_D;
                if (r < I_IN) { transpose_item(INF(9, l, D * DIN), D, DIN, WPTR(l, WL_IN), 0, INF(7, l, D), scr, r, 64, c.lane); continue; } r -= I_IN;
                if (r < I_Q) { transpose_item(INF(11, l, 256 * 768), 256, 768, WPTR(l, WL_Q), 0, INF(10, l, 256), scr, r, 24, c.lane); continue; } r -= I_Q;
                if (r < I_KV) { transpose_item(INF(13, l, 128 * 1024), 128, 1024, WPTR(l, WL_KV), 0, INF(12, l, 128), scr, r, 32, c.lane); continue; } r -= I_KV;
                transpose_item(INF(18, l, D * D), D, D, WPTR(l, WL_OUT), 0, nullptr, scr, r, 32, c.lane);
            }
            { const int* pos = (const int*)ap->in[1];
              for (int i = c.bid * 512 + c.tid; i < T * 16; i += c.G * 512) {
                  const int t = i >> 4, j = i & 15;
                  const float inv = exp2f(-(float)(2 * j) * (1.0f / 32.0f) * 13.287712379549449f);
                  const float ang = (float)pos[t] * inv;
                  const double rv = (double)ang * 0.15915494309189535; const float rr = (float)(rv - rint(rv));
                  cs[i] = __builtin_amdgcn_cosf(rr); sn[i] = __builtin_amdgcn_sinf(rr);
              } }
            resnorm_phase(c, nullptr, (const float*)ap->in[0], xb, nullptr, nullptr, 0.f, rrow);
            continue;
        }
        const int l = (ph - 1) / 12, sp = (ph - 1) % 12;
        if (sp == 0 || sp == 9) {
            pg8::Gemm g{xb, WPTR(l, sp == 0 ? WL_GU1 : WL_GU2), T, 2 * FF, D, D}; pg8::StaticOrder S; S.init(T, 2 * FF, c.G, c.bid);
            pg8::EpiSwiglu E{Rb, FF, rrow};
            for (int rep = 0; rep <= PROBE_GU; ++rep)
            pg8::gemm_phase<pg8::EpiSwiglu>(ldsl, g, S, E, wave_s);
        } else if (sp == 1 || sp == 10) {
            pg8::Gemm g{Rb, WPTR(l, sp == 1 ? WL_D1 : WL_D2), T, D, FF, FF}; pg8::StaticOrder S; S.init(T, D, c.G, c.bid);
            const bool fin = (l == 1 && sp == 10);
            pg8::EpiRes E{xb, fin ? ap->out : nullptr, sp == 1 ? INF(3, l, D) : INF(20, l, D), 0.5f, xch, (unsigned*)(ws + 65536) + (size_t)(l * 3 + (sp == 1 ? 0 : 2)) * 128 * 64, rrow};
            pg8::gemm_phase<pg8::EpiRes>(ldsl, g, S, E, wave_s);
        } else if (sp == 2) {
            FRESH_CTX();
            resnorm_phase(c, Fb, nullptr, xb, nullptr, INF(3, l, D), 0.5f, rrow);
        } else if (sp == 3) {
            pg8::Gemm g{xb, WPTR(l, WL_IN), T, DINP, D, D}; pg8::StaticOrder S; S.init(T, DINP, c.G, c.bid);
            pg8::EpiPlain E{proj, DINP, ssq, sskv, rrow};
            pg8::gemm_phase<pg8::EpiPlain>(ldsl, g, S, E, wave_s);
        } else if (sp == 4) {
            { pg8::Gemm g{proj + C_MQ, WPTR(l, WL_Q), T, 768, 256, DINP}; pg8::StaticOrder S; S.init(T, 768, c.G, c.bid);
              pg8::EpiQ E{Qb, ssq, cs, sn};
              for (int rep = 0; rep <= PROBE_SMALL; ++rep) pg8::gemm_phase<pg8::EpiQ>(ldsl, g, S, E, wave_s); }
            __syncthreads();
            { pg8::Gemm g{proj + C_MKV, WPTR(l, WL_KV), T, 1024, 128, DINP}; pg8::StaticOrder S; S.init(T, 1024, c.G, c.bid);
              pg8::EpiKV E{Kbuf, Vbuf, sskv, proj, cs, sn};
              for (int rep = 0; rep <= PROBE_SMALL; ++rep) { __syncthreads(); pg8::gemm_phase<pg8::EpiKV>(ldsl, g, S, E, wave_s); } }
            __syncthreads();
            float* wgl = (float*)(lds + WG_LDS_OFF);
            { const int t_ = fresh_tid(wave_s); const float* wsrc = INF(14, l, 16 * 128); const float* bsrc = INF(15, l, 128);
              for (int i = t_; i < 2048 + 128; i += NWAVES * 64) wgl[i] = (i < 2048) ? wsrc[i] : bsrc[i - 2048]; }
            __syncthreads();
            ChunkIn ci{proj, INF(14, l, 16 * 128), INF(15, l, 128), cs, sn};
            unsigned char* wl = lds + c.wave * 16384;
            for (int rep = 0; rep <= PROBE_CHUNK; ++rep)
            for (int u = gw; u < 4096; u += NGW) {
                const int lane2 = fresh_tid(wave_s) & 63;
                if (u < 2048) chunk_pass_a<true>(ci, wgl, u, wl, lane2, dS, dec);
                else chunk_pass_a<false>(ci, wgl, u - 2048, wl, lane2, dS + (size_t)2048 * 2048, dec + 2048 * 32);
            }
        } else if (sp == 5) {
            FRESH_CTX();
            for (int gi = c.bid * 512 + c.tid; gi < 131072; gi += c.G * 512) {
                const int e = gi & 63, d = (gi >> 6) & 31, h = (gi >> 11) & 3, b = (gi >> 13) & 7, ty = gi >> 16;
                float* base = dS + (size_t)ty * 2048 * 2048; const float* db = dec + (size_t)ty * 2048 * 32;
                float s = 0.f;
                for (int n0 = 0; n0 < 64; n0 += 16) {
                    float ds[16], dc[16];
#pragma unroll
                    for (int j = 0; j < 16; ++j) { const int unit = (b * 64 + n0 + j) * 4 + h; ds[j] = base[(size_t)unit * 2048 + d * 64 + e]; dc[j] = db[unit * 32 + d]; }
#pragma unroll
                    for (int j = 0; j < 16; ++j) { const int unit = (b * 64 + n0 + j) * 4 + h; base[(size_t)unit * 2048 + d * 64 + e] = s; s = dc[j] * s + ds[j]; }
                }
            }
            unsigned* scan_cnt = (unsigned*)(ws + 65536 + 2 * 196608) + 64 * l;
            asm volatile("s_waitcnt vmcnt(0)" ::: "memory"); __syncthreads();
            if (c.tid == 0) { __builtin_amdgcn_fence(__ATOMIC_RELEASE, "agent"); asm volatile("s_waitcnt vmcnt(0)" ::: "memory"); __hip_atomic_fetch_add(scan_cnt, 1u, __ATOMIC_RELAXED, __HIP_MEMORY_SCOPE_AGENT); }
            const int vcu = (c.G % 8 == 0) ? (c.bid % 8) * (c.G / 8) + c.bid / 8 : c.bid;
            for (int rep = 0; rep <= PROBE_ATTN; ++rep)
            for (int i = vcu; i < 1024; i += c.G) {
                const int j = i >> 8, ii = i & 255, bh = ii >> 2, s4 = ii & 3;
                const int qb = (j == 0) ? s4 : (j == 1) ? 7 - s4 : (j == 2) ? 8 + s4 : 15 - s4;
                attn_unit(c, bh, qb, Qb, Kbuf, Vbuf, omix);
            }
            FRESH_CTX();
            __syncthreads();
            if (c.tid == 0) { unsigned spins = 0; while (__hip_atomic_load(scan_cnt, __ATOMIC_RELAXED, __HIP_MEMORY_SCOPE_AGENT) < (unsigned)c.G) { __builtin_amdgcn_s_sleep(2); if (++spins > (1u << 22)) break; }
                              __builtin_amdgcn_fence(__ATOMIC_ACQUIRE, "agent"); asm volatile("s_waitcnt vmcnt(0)" ::: "memory"); }
            __syncthreads();
            float* wgl = (float*)(lds + WG_LDS_OFF);
            { const int t_ = fresh_tid(wave_s); const float* wsrc = INF(14, l, 16 * 128); const float* bsrc = INF(15, l, 128);
              for (int i = t_; i < 2048 + 128; i += NWAVES * 64) wgl[i] = (i < 2048) ? wsrc[i] : bsrc[i - 2048]; }
            __syncthreads();
            ChunkIn ci{proj, INF(14, l, 16 * 128), INF(15, l, 128), cs, sn};
            unsigned char* wl = lds + c.wave * 16384;
            for (int rep = 0; rep <= PROBE_CHUNK; ++rep)
            for (int u = gw; u < 4096; u += NGW) {
                const int lane2 = fresh_tid(wave_s) & 63;
                if (u < 2048) chunk_pass_c<true>(ci, wgl, u, wl, lane2, dS, INF(16, l, 64), omix);
                else chunk_pass_c<false>(ci, wgl, u - 2048, wl, lane2, dS + (size_t)2048 * 2048, INF(17, l, 64), omix);
            }
        } else if (sp == 7) {
            pg8::Gemm g{omix, WPTR(l, WL_OUT), T, D, D, D}; pg8::StaticOrder S; S.init(T, D, c.G, c.bid);
            pg8::EpiRes E{xb, nullptr, INF(8, l, D), 1.0f, xch, (unsigned*)(ws + 65536) + (size_t)(l * 3 + 1) * 128 * 64, rrow};
            pg8::gemm_phase<pg8::EpiRes>(ldsl, g, S, E, wave_s);
        } else if (sp == 8) {
            FRESH_CTX();
            resnorm_phase(c, Fb, nullptr, xb, nullptr, INF(8, l, D), 1.0f, rrow);
        } else {
            FRESH_CTX();
            resnorm_phase(c, Fb, nullptr, xb, (l == 1) ? ap->out : nullptr, INF(20, l, D), 0.5f, (l == 0) ? rrow : nullptr);
        }
    }
}

constexpr int N_PHASES = 25;

extern "C" void kernel_launch(void* const* d_in, const int* in_sizes, int n_in, void* d_out, int out_size, void* d_ws, size_t ws_size, hipStream_t stream) {
    static int grid = 0;
    if (grid == 0) {
        if (n_in != 24 || in_sizes[0] != T * D || out_size != T * D || ws_size < WS_END) { fprintf(stderr, "kernel_launch: unexpected shapes (n_in %d, in0 %d, out %d, ws %zu < %zu)\n", n_in, n_in > 0 ? in_sizes[0] : -1, out_size, ws_size, (size_t)WS_END); grid = -1; return; }
        int dev = 0, cus = 0, per_cu = 0;
        hipGetDevice(&dev); hipDeviceGetAttribute(&cus, hipDeviceAttributeMultiprocessorCount, dev);
        if (hipFuncSetAttribute((const void*)mega_fwd, hipFuncAttributeMaxDynamicSharedMemorySize, LDS_BYTES) != hipSuccess) { fprintf(stderr, "kernel_launch: hipFuncSetAttribute failed\n"); grid = -1; return; }
        if (hipOccupancyMaxActiveBlocksPerMultiprocessor(&per_cu, (const void*)mega_fwd, NWAVES * 64, LDS_BYTES) != hipSuccess || per_cu < 1) { fprintf(stderr, "kernel_launch: occupancy query says %d\n", per_cu); per_cu = 1; }
        (void)hipGetLastError();
        grid = cus * per_cu;
    }
    if (grid < 0) return;
    if (hipMemsetAsync((char*)d_ws + WS_CTL, 0, 1 << 20, stream) != hipSuccess) { fprintf(stderr, "kernel_launch: memset of the barrier words failed\n"); return; }
    Args a{};
    for (int i = 0; i < 24; ++i) a.in[i] = d_in[i];
    a.out = (float*)d_out; a.ws = (unsigned char*)d_ws;
#if MK_ONE_LAUNCH
    a.ph_lo = 0; a.ph_hi = N_PHASES;
    void* kargs[] = {&a};
    hipError_t e = hipLaunchCooperativeKernel((const void*)mega_fwd, dim3(grid), dim3(NWAVES * 64), kargs, LDS_BYTES, stream);
    if (e != hipSuccess) fprintf(stderr, "cooperative launch failed: %s (grid %d)\n", hipGetErrorString(e), grid);
#else
    for (int p = 0; p < N_PHASES; ++p) {
        a.ph_lo = p; a.ph_hi = p + 1;
        hipLaunchKernelGGL(mega_fwd, dim3(grid), dim3(NWAVES * 64), LDS_BYTES, stream, a);
    }
#endif
}
```
